# Optimizing an MI355X kernel written in HIP

```python
import math
import jax, jax.numpy as jnp
from jax import lax
import numpy as np

D_MODEL = 1024
BATCH = 2
SEQ = 8192
DEPTH = 2

CTX_LEN = 256
GRID_W = 64
N_MOD = 9
D_FF = 2816
EPS = 1e-6
NEG_INF = -1e30
Q_BLOCK = 128
ROPE_THETA = 10000.0

NA_HEADS = 4
NA_HEAD_DIM = 64
NA_WIN_ROWS = 8
NA_WIN_COLS = 16
NA_QCOLS = NA_WIN_COLS
NA_BAND_COLS = 2 * NA_WIN_COLS
NA_WIDTH = NA_HEADS * NA_HEAD_DIM

POOL_WINDOWS = (2, 4, 8, 16)
POOL_GROUPS = len(POOL_WINDOWS)
POOL_GROUP_DIM = 64
POOL_WIDTH = POOL_GROUPS * POOL_GROUP_DIM

DIFF_HEADS = 4
DIFF_QK_DIM = 64
DIFF_V_DIM = 2 * DIFF_QK_DIM
DIFF_QK_WIDTH = DIFF_HEADS * 2 * DIFF_QK_DIM
DIFF_WIDTH = DIFF_HEADS * DIFF_V_DIM

MIX_WIDTH = NA_WIDTH + POOL_WIDTH + DIFF_WIDTH
IN_WIDTH = 3 * NA_WIDTH + POOL_WIDTH + 2 * DIFF_QK_WIDTH + DIFF_WIDTH
IN_SPLITS = (NA_WIDTH, 2 * NA_WIDTH, 3 * NA_WIDTH, 3 * NA_WIDTH + POOL_WIDTH,
             3 * NA_WIDTH + POOL_WIDTH + DIFF_QK_WIDTH, 3 * NA_WIDTH + POOL_WIDTH + 2 * DIFF_QK_WIDTH)

kernel_name = 'hybrid_natten_pool_diffattn_dit'


def rms_norm(x, g):
    xf = x.astype(jnp.float32)
    y = xf * lax.rsqrt(jnp.mean(xf * xf, axis=-1, keepdims=True) + EPS)
    return (y * g.astype(jnp.float32)).astype(x.dtype)


def sandwich_in(x, mods, idx, g_pre):
    shift, scale = mods[3 * idx], mods[3 * idx + 1]
    return rms_norm(x, g_pre) * (1 + scale) + shift


def sandwich_out(x, y, mods, idx, g_post, res_w):
    gate = mods[3 * idx + 2]
    return x + res_w * gate * rms_norm(y, g_post)


def swiglu(h, w1, w2):
    a, b = jnp.split(h @ w1, 2, axis=-1)
    return (jax.nn.silu(a) * b) @ w2


def axial_rope_tables(n_tokens, dim):
    t = jnp.arange(n_tokens, dtype=jnp.int32)
    row = (t // GRID_W).astype(jnp.float32)
    col = (t % GRID_W).astype(jnp.float32)
    n_freq = dim // 4
    inv_freq = jnp.power(ROPE_THETA, -jnp.arange(n_freq, dtype=jnp.float32) / n_freq)
    ang = jnp.concatenate([row[:, None] * inv_freq, col[:, None] * inv_freq], axis=-1)
    return jnp.cos(ang), jnp.sin(ang)


def apply_rope(x, cos, sin):
    x1, x2 = jnp.split(x, 2, axis=-1)
    c = cos[None, :, None, :].astype(x.dtype)
    s = sin[None, :, None, :].astype(x.dtype)
    return jnp.concatenate([x1 * c - x2 * s, x1 * s + x2 * c], axis=-1)


def dense_attention(q, k, v):
    s = jnp.einsum('bqhd,bkhd->bhqk', q, k, preferred_element_type=jnp.float32)
    p = jax.nn.softmax(s, axis=-1).astype(v.dtype)
    return jnp.einsum('bhqk,bkhd->bqhd', p, v)


def neighbourhood_attention(q, k, v, k_ctx, v_ctx, rpb):
    B, S, H, dh = q.shape
    rows = S // GRID_W
    win_r = min(NA_WIN_ROWS, rows)
    n_cb = GRID_W // NA_QCOLS
    r = jnp.arange(rows)
    row_idx = jnp.clip(r - win_r // 2, 0, rows - win_r)[:, None] + jnp.arange(win_r)[None, :]
    cb = jnp.arange(n_cb)
    band_idx = (jnp.clip(cb * NA_QCOLS - NA_WIN_COLS // 2, 0, GRID_W - NA_BAND_COLS)[:, None]
                + jnp.arange(NA_BAND_COLS)[None, :])
    q_col = cb[:, None] * NA_QCOLS + jnp.arange(NA_QCOLS)[None, :]
    win_c0 = jnp.clip(q_col - NA_WIN_COLS // 2, 0, GRID_W - NA_WIN_COLS)[:, :, None]
    key_col = band_idx[:, None, :]
    in_win = (key_col >= win_c0) & (key_col < win_c0 + NA_WIN_COLS)
    d_row = (row_idx - r[:, None]) + NA_WIN_ROWS - 1
    d_col = jnp.clip(key_col - q_col[:, :, None], 1 - NA_WIN_COLS, NA_WIN_COLS - 1) + NA_WIN_COLS - 1
    bias = rpb.astype(jnp.float32)[:, d_row[:, None, None, :, None], d_col[None, :, :, None, :]]
    bias = jnp.where(in_win[None, None, :, :, None, :], bias, NEG_INF)

    qg = q.reshape(B, rows, n_cb, NA_QCOLS, H, dh)
    kg = k.reshape(B, rows, GRID_W, H, dh)
    vg = v.reshape(B, rows, GRID_W, H, dh)
    gi_r = row_idx[:, None, :, None]
    gi_c = band_idx[None, :, None, :]
    kb = kg[:, gi_r, gi_c]
    vb = vg[:, gi_r, gi_c]
    n_loc = win_r * NA_BAND_COLS
    s_loc = jnp.einsum('brnqhd,brnkwhd->bhrnqkw', qg, kb, preferred_element_type=jnp.float32) + bias
    s_loc = s_loc.reshape(B, H, rows, n_cb, NA_QCOLS, n_loc)
    s_ctx = jnp.einsum('brnqhd,bchd->bhrnqc', qg, k_ctx, preferred_element_type=jnp.float32)
    p = jax.nn.softmax(jnp.concatenate([s_loc, s_ctx], axis=-1), axis=-1).astype(v.dtype)
    p_loc = p[..., :n_loc].reshape(B, H, rows, n_cb, NA_QCOLS, win_r, NA_BAND_COLS)
    p_ctx = p[..., n_loc:]
    out = (jnp.einsum('bhrnqkw,brnkwhd->brnqhd', p_loc, vb)
           + jnp.einsum('bhrnqc,bchd->brnqhd', p_ctx, v_ctx))
    return out.reshape(B, S, H * dh)


def pool_mix(u, w, scale):
    B, L, _ = u.shape
    ug = u.reshape(B, L, POOL_GROUPS, POOL_GROUP_DIM).astype(jnp.float32)
    cs = jnp.concatenate([jnp.zeros_like(ug[:, :1]), jnp.cumsum(ug, axis=1)], axis=1)
    half = jnp.array(POOL_WINDOWS, dtype=jnp.int32) // 2
    t = jnp.arange(L, dtype=jnp.int32)[:, None]
    lo = jnp.clip(t - half[None, :], 0, L)
    hi = jnp.clip(t + half[None, :], 0, L)
    gi = jnp.arange(POOL_GROUPS)[None, :]
    win_mean = (cs[:, hi, gi] - cs[:, lo, gi]) / (hi - lo).astype(jnp.float32)[None, :, :, None]
    pooled = (win_mean - ug).astype(u.dtype)
    y = jnp.einsum('blgc,gcd->blgd', pooled, w)
    return y.reshape(B, L, POOL_WIDTH) * scale


def diff_attention(q1, q2, k1, k2, v, lam):
    B, L, H, d = q1.shape
    nb = L // Q_BLOCK

    def to_blocks(t):
        return t.reshape(B, nb, Q_BLOCK, H, d).transpose(1, 0, 2, 3, 4)

    def one_block(qb):
        qb1, qb2 = qb
        a1 = jax.nn.softmax(jnp.einsum('bqhd,bkhd->bhqk', qb1, k1, preferred_element_type=jnp.float32), axis=-1)
        a2 = jax.nn.softmax(jnp.einsum('bqhd,bkhd->bhqk', qb2, k2, preferred_element_type=jnp.float32), axis=-1)
        p = (a1 - lam * a2).astype(v.dtype)
        return jnp.einsum('bhqk,bkhe->bqhe', p, v)

    out = lax.map(one_block, (to_blocks(q1), to_blocks(q2)))
    return out.transpose(1, 0, 2, 3, 4).reshape(B, L, H, v.shape[-1])


def project_heads(h, w_in):
    naq, nak, nav, pin, dq, dk, dv = jnp.split(h @ w_in, IN_SPLITS, axis=-1)
    B, L = h.shape[:2]
    dq = dq.reshape(B, L, DIFF_HEADS, 2, DIFF_QK_DIM)
    dk = dk.reshape(B, L, DIFF_HEADS, 2, DIFF_QK_DIM)
    return (naq.reshape(B, L, NA_HEADS, NA_HEAD_DIM) * (NA_HEAD_DIM ** -0.5),
            nak.reshape(B, L, NA_HEADS, NA_HEAD_DIM),
            nav.reshape(B, L, NA_HEADS, NA_HEAD_DIM),
            pin,
            dq[..., 0, :] * (DIFF_QK_DIM ** -0.5), dq[..., 1, :] * (DIFF_QK_DIM ** -0.5),
            dk[..., 0, :], dk[..., 1, :],
            dv.reshape(B, L, DIFF_HEADS, DIFF_V_DIM))


def token_mixing(h_lat, h_ctx, w_in, w_out, rpb, pool_w, pool_scale, lam_vec, subln_g, lam_init, cos, sin, with_ctx_out):
    B, S, _ = h_lat.shape
    C = h_ctx.shape[1]
    lf = lam_vec.astype(jnp.float32)
    lam = jnp.exp(jnp.sum(lf[0] * lf[1])) - jnp.exp(jnp.sum(lf[2] * lf[3])) + lam_init
    aq, ak, av, pin, q1, q2, k1, k2, v = project_heads(h_lat, w_in)
    aqc, akc, avc, pinc, q1c, q2c, k1c, k2c, vc = project_heads(h_ctx, w_in)

    a_lat = neighbourhood_attention(aq, ak, av, akc, avc, rpb)
    b_lat = pool_mix(pin, pool_w, pool_scale)
    q1, q2, k1, k2 = [apply_rope(t, cos, sin) for t in (q1, q2, k1, k2)]
    c_lat = diff_attention(q1, q2,
                           jnp.concatenate([k1, k1c], axis=1),
                           jnp.concatenate([k2, k2c], axis=1),
                           jnp.concatenate([v, vc], axis=1), lam)
    c_lat = (rms_norm(c_lat, subln_g) * (1 - lam_init)).reshape(B, S, DIFF_WIDTH)
    y_lat = jnp.concatenate([a_lat, b_lat, c_lat], axis=-1) @ w_out
    if not with_ctx_out:
        return y_lat, None

    a_ctx = dense_attention(aqc, akc, avc).reshape(B, C, NA_WIDTH)
    b_ctx = pool_mix(pinc, pool_w, pool_scale)
    c_ctx = diff_attention(q1c, q2c, k1c, k2c, vc, lam)
    c_ctx = (rms_norm(c_ctx, subln_g) * (1 - lam_init)).reshape(B, C, DIFF_WIDTH)
    y_ctx = jnp.concatenate([a_ctx, b_ctx, c_ctx], axis=-1) @ w_out
    return y_lat, y_ctx


def setup_inputs(seed: int = 0) -> dict:
    key = jax.random.key(seed)
    ks = jax.random.split(key, 16)
    f32 = jnp.float32
    nrm = lambda k, shape: jax.random.normal(k, shape, dtype=f32)
    n_rpb_r, n_rpb_c = 2 * NA_WIN_ROWS - 1, 2 * NA_WIN_COLS - 1
    return {
        'x': nrm(ks[0], (BATCH, SEQ, D_MODEL)),
        'c': nrm(ks[1], (BATCH, D_MODEL)),
        'ctx': nrm(ks[2], (BATCH, CTX_LEN, D_MODEL)),
        'c_ctx': nrm(ks[3], (D_MODEL,)),
        'w_ada': nrm(ks[4], (DEPTH, D_MODEL, N_MOD * D_MODEL)) * D_MODEL ** -0.5,
        'b_ada': nrm(ks[5], (DEPTH, N_MOD * D_MODEL)) * 0.02,
        'norm_g': 1.0 + 0.05 * nrm(ks[6], (DEPTH, 6, D_MODEL)),
        'ffn_w1': nrm(ks[7], (DEPTH, 2, D_MODEL, 2 * D_FF)) * D_MODEL ** -0.5,
        'ffn_w2': nrm(ks[8], (DEPTH, 2, D_FF, D_MODEL)) * D_FF ** -0.5,
        'w_in': nrm(ks[9], (DEPTH, D_MODEL, IN_WIDTH)) * D_MODEL ** -0.5,
        'w_out': nrm(ks[10], (DEPTH, MIX_WIDTH, D_MODEL)) * MIX_WIDTH ** -0.5,
        'na_rpb': nrm(ks[11], (DEPTH, NA_HEADS, n_rpb_r, n_rpb_c)) * 0.2,
        'pool_w': nrm(ks[12], (DEPTH, POOL_GROUPS, POOL_GROUP_DIM, POOL_GROUP_DIM)) * POOL_GROUP_DIM ** -0.5,
        'pool_scale': 1.0 + 0.1 * nrm(ks[13], (DEPTH, POOL_WIDTH)),
        'diff_lambda': nrm(ks[14], (DEPTH, 4, DIFF_QK_DIM)) * 0.1,
        'diff_subln_g': 1.0 + 0.05 * nrm(ks[15], (DEPTH, DIFF_V_DIM)),
    }


def reference(x, c, ctx, c_ctx, w_ada, b_ada, norm_g, ffn_w1, ffn_w2, w_in, w_out, na_rpb, pool_w, pool_scale, diff_lambda, diff_subln_g):
    S = x.shape[1]
    cos, sin = axial_rope_tables(S, DIFF_QK_DIM)
    silu_c = jax.nn.silu(c)
    silu_cc = jax.nn.silu(c_ctx)
    x_lat, x_ctx = x, ctx
    for layer in range(DEPTH):
        last = layer == DEPTH - 1
        m_lat = jnp.split((silu_c @ w_ada[layer] + b_ada[layer])[:, None, :], N_MOD, axis=-1)
        m_ctx = jnp.split(silu_cc @ w_ada[layer] + b_ada[layer], N_MOD, axis=-1)
        g = norm_g[layer]
        lam_init = 0.8 - 0.6 * math.exp(-0.3 * layer)

        x_lat = sandwich_out(x_lat, swiglu(sandwich_in(x_lat, m_lat, 0, g[0]), ffn_w1[layer, 0], ffn_w2[layer, 0]), m_lat, 0, g[1], 0.5)
        x_ctx = sandwich_out(x_ctx, swiglu(sandwich_in(x_ctx, m_ctx, 0, g[0]), ffn_w1[layer, 0], ffn_w2[layer, 0]), m_ctx, 0, g[1], 0.5)

        h_lat = sandwich_in(x_lat, m_lat, 1, g[2])
        h_ctx = sandwich_in(x_ctx, m_ctx, 1, g[2])
        y_lat, y_ctx = token_mixing(h_lat, h_ctx, w_in[layer], w_out[layer], na_rpb[layer], pool_w[layer], pool_scale[layer],
                                    diff_lambda[layer], diff_subln_g[layer], lam_init, cos, sin, not last)
        x_lat = sandwich_out(x_lat, y_lat, m_lat, 1, g[3], 1.0)

        x_lat = sandwich_out(x_lat, swiglu(sandwich_in(x_lat, m_lat, 2, g[4]), ffn_w1[layer, 1], ffn_w2[layer, 1]), m_lat, 2, g[5], 0.5)
        if not last:
            x_ctx = sandwich_out(x_ctx, y_ctx, m_ctx, 1, g[3], 1.0)
            x_ctx = sandwich_out(x_ctx, swiglu(sandwich_in(x_ctx, m_ctx, 2, g[4]), ffn_w1[layer, 1], ffn_w2[layer, 1]), m_ctx, 2, g[5], 0.5)
    return x_lat
```

```cpp
#include <hip/hip_runtime.h>
#include <hip/hip_cooperative_groups.h>
#include <cstdio>
#include <cstdint>
namespace pg8 {
#define PG8_LAS __attribute__((address_space(3)))
typedef unsigned short bf16_t;
typedef short bf16x8 __attribute__((ext_vector_type(8)));
typedef float f32x4 __attribute__((ext_vector_type(4)));
typedef unsigned u32x4 __attribute__((ext_vector_type(4)));
constexpr int BM = 256, BK = 64, HALF = 128, HTB = HALF * BK * 2  , STAGE_BYTES = 8 * HTB, NXCD = 8, WGM = 8;

__host__ __device__ __forceinline__ int lds_byte(int r, int c) { const int st = (r >> 4) * 2 + (c >> 5), rr = r & 15, cc = c & 31, ob = rr * 64 + cc * 2; return st * 1024 + (ob ^ (((ob >> 9) & 1) << 5)); }
__host__ __device__ __forceinline__ void stage_rc(int b, int& R, int& C) { const int st = b / 1024, sb = b % 1024, swz = sb ^ (((sb >> 9) & 1) << 5); R = (st >> 1) * 16 + swz / 64; C = (st & 1) * 32 + (swz % 64) / 2; }
__host__ __device__ __forceinline__ int perm32(int rho) { const int n = rho >> 4, i = rho & 15; return 8 * (i >> 2) + 4 * n + (i & 3); }

struct Unit { int pm, pn; };
struct Gemm { const bf16_t* A; const bf16_t* Bt; int M, N, K; };

struct StaticOrder {
    int nM, nN, nwg, G, c;
    __host__ __device__ void init(int M, int N, int G_, int c_) { nM = M / BM; nN = N / BM; nwg = nM * nN; G = G_; c = c_; }
    __host__ __device__ bool next(int i, Unit& u) const {
        const long L = (long)i * G + c; if (L >= nwg) return false;
        int wgid = (int)L; { const int q = nwg / NXCD, r = nwg % NXCD, xcd = wgid % NXCD, off = wgid / NXCD; wgid = (xcd < r ? xcd * (q + 1) : r * (q + 1) + (xcd - r) * q) + off; }
        const int nig = WGM * nN, gid = wgid / nig, fm = gid * WGM, gsz = (nM - fm) < WGM ? (nM - fm) : WGM;
        u.pm = fm + ((wgid % nig) % gsz); u.pn = (wgid % nig) / gsz; return true;
    }
    __device__ __forceinline__ void a_ready(const Unit&) const {}
    __device__ __forceinline__ void done(const Unit&) const {}
};

typedef float f32x2 __attribute__((ext_vector_type(2)));
typedef __bf16 pg8_bf16x2 __attribute__((ext_vector_type(2)));
__device__ __forceinline__ unsigned cvt_pk_bf16(float lo, float hi) { f32x2 v = {lo, hi}; pg8_bf16x2 b = __builtin_convertvector(v, pg8_bf16x2); return __builtin_bit_cast(unsigned, b); }
typedef unsigned u32x2 __attribute__((ext_vector_type(2)));
struct EpiSwiglu {
    static constexpr bool PERM = true, AFTER_DRAIN = false;
    bf16_t* O; int ldc;
    __device__ __forceinline__ void operator()(const f32x4 (&acc)[2][2][4][2], const Unit& u, int wr, int wc, int fr, int fq) const {
        const int row0 = u.pm * BM + wr * 64 + fr, col0 = u.pn * 128 + wc * 32 + 8 * fq;
#pragma unroll
        for (int ai = 0; ai < 2; ++ai)
#pragma unroll
            for (int m = 0; m < 4; ++m) {
                bf16_t* rowp = O + (size_t)(row0 + ai * HALF + m * 16) * ldc + col0;
                float r[8];
#pragma unroll
                for (int n = 0; n < 2; ++n)
#pragma unroll
                    for (int e = 0; e < 4; ++e) {
                        const float a = acc[ai][0][m][n][e], b = acc[ai][1][m][n][e];
                        r[n * 4 + e] = a * b * __builtin_amdgcn_rcpf(1.0f + __builtin_amdgcn_exp2f(-a));
                    }
                u32x4 w; w.x = cvt_pk_bf16(r[0], r[1]); w.y = cvt_pk_bf16(r[2], r[3]); w.z = cvt_pk_bf16(r[4], r[5]); w.w = cvt_pk_bf16(r[6], r[7]);
                *(u32x4*)rowp = w;
            }
    }
};
struct EpiY {
    static constexpr bool PERM = true, AFTER_DRAIN = false;
    bf16_t* O; int ldc;
    __device__ __forceinline__ void operator()(const f32x4 (&acc)[2][2][4][2], const Unit& u, int wr, int wc, int fr, int fq) const {
        const int row0 = u.pm * BM + wr * 64 + fr, col0 = u.pn * BM + wc * 32 + 8 * fq;
#pragma unroll
        for (int ai = 0; ai < 2; ++ai)
#pragma unroll
            for (int m = 0; m < 4; ++m) {
                bf16_t* rowp = O + (size_t)(row0 + ai * HALF + m * 16) * ldc + col0;
#pragma unroll
                for (int bj = 0; bj < 2; ++bj) { const f32x4 v0 = acc[ai][bj][m][0], v1 = acc[ai][bj][m][1];
                    u32x4 w; w.x = cvt_pk_bf16(v0[0], v0[1]); w.y = cvt_pk_bf16(v0[2], v0[3]); w.z = cvt_pk_bf16(v1[0], v1[1]); w.w = cvt_pk_bf16(v1[2], v1[3]);
                    *(u32x4*)(rowp + bj * HALF) = w; }
            }
    }
};
struct EpiProj {
    static constexpr bool PERM = true, AFTER_DRAIN = false;
    bf16_t* O; int ldc; const float* cs; float qscale;
    __device__ __forceinline__ void operator()(const f32x4 (&acc)[2][2][4][2], const Unit& u, int wr, int wc, int fr, int fq) const {
        const int row0 = u.pm * BM + wr * 64 + fr;
        const bool rope = (u.pn >= 4 && u.pn < 8);
        if (!rope) {
            const int col0 = u.pn * BM + wc * 32 + 8 * fq;
#pragma unroll
            for (int ai = 0; ai < 2; ++ai)
#pragma unroll
                for (int m = 0; m < 4; ++m) {
                    bf16_t* rowp = O + (size_t)(row0 + ai * HALF + m * 16) * ldc + col0;
#pragma unroll
                    for (int bj = 0; bj < 2; ++bj) {
                        const f32x4 v0 = acc[ai][bj][m][0], v1 = acc[ai][bj][m][1];
                        u32x4 w; w.x = cvt_pk_bf16(v0[0], v0[1]); w.y = cvt_pk_bf16(v0[2], v0[3]); w.z = cvt_pk_bf16(v1[0], v1[1]); w.w = cvt_pk_bf16(v1[2], v1[3]);
                        *(u32x4*)(rowp + bj * HALF) = w;
                    }
                }
        } else {
            const bool lat = (u.pm < 64);
            const int col0 = u.pn * BM + wc * 64 + 8 * fq;
#pragma unroll
            for (int ai = 0; ai < 2; ++ai)
#pragma unroll
                for (int m = 0; m < 4; ++m) {
                    const int row = row0 + ai * HALF + m * 16;
                    bf16_t* rowp = O + (size_t)row * ldc + col0;
                    f32x4 c0 = (f32x4){1.f, 1.f, 1.f, 1.f}, c1 = c0, s0 = (f32x4){0.f, 0.f, 0.f, 0.f}, s1 = s0;
                    if (lat) { const float* cp = cs + (size_t)(row & 8191) * 64 + 8 * fq; c0 = *(const f32x4*)cp; c1 = *(const f32x4*)(cp + 4); s0 = *(const f32x4*)(cp + 32); s1 = *(const f32x4*)(cp + 36); }
                    const f32x4 a0 = acc[ai][0][m][0], a1 = acc[ai][0][m][1], b0 = acc[ai][1][m][0], b1 = acc[ai][1][m][1];
                    const f32x4 y10 = a0 * c0 - b0 * s0, y11 = a1 * c1 - b1 * s1, y20 = a0 * s0 + b0 * c0, y21 = a1 * s1 + b1 * c1;
                    u32x4 w; w.x = cvt_pk_bf16(y10[0], y10[1]); w.y = cvt_pk_bf16(y10[2], y10[3]); w.z = cvt_pk_bf16(y11[0], y11[1]); w.w = cvt_pk_bf16(y11[2], y11[3]);
                    *(u32x4*)rowp = w;
                    w.x = cvt_pk_bf16(y20[0], y20[1]); w.y = cvt_pk_bf16(y20[2], y20[3]); w.z = cvt_pk_bf16(y21[0], y21[1]); w.w = cvt_pk_bf16(y21[2], y21[3]);
                    *(u32x4*)(rowp + 32) = w;
                }
        }
    }
};
struct OrderUpCtxFirst {
    int c; unsigned* cnt;
    __device__ __forceinline__ bool next(int i, Unit& u) const {
        int L;
        if (c < 248) { L = i * 248 + c; if (L >= 1428) return false; } else { if (i >= 3) return false; L = 1428 + (c - 248) * 3 + i; }
        if (L < 44) { u.pm = 64 + L / 22; u.pn = L % 22; return true; }
        int wgid = L - 44; const int nwg = 64 * 22; { const int q = nwg / NXCD, r = nwg % NXCD, xcd = wgid % NXCD, off = wgid / NXCD; wgid = (xcd < r ? xcd * (q + 1) : r * (q + 1) + (xcd - r) * q) + off; }
        const int nig = WGM * 22; const int gid = wgid / nig, fm = gid * WGM;
        u.pm = fm + ((wgid % nig) % WGM); u.pn = (wgid % nig) / WGM; return true;
    }
    __device__ __forceinline__ void a_ready(const Unit&) const {}
    __device__ __forceinline__ void done(const Unit& u) const {
        if (u.pm >= 64) {
            asm volatile("s_waitcnt vmcnt(0)" ::: "memory");
            __builtin_amdgcn_fence(__ATOMIC_RELEASE, "agent");
            asm volatile("s_waitcnt vmcnt(0)" ::: "memory");
            if ((threadIdx.x & 63) == 0) __hip_atomic_fetch_add(cnt, 1u, __ATOMIC_RELAXED, __HIP_MEMORY_SCOPE_AGENT);
        }
    }
};
struct OrderCtxTail {
    int c;
    __device__ __forceinline__ bool next(int i, Unit& u) const { if (i > 0 || c < 248) return false; const int j = c - 248; u.pm = 64 + (j >> 2); u.pn = j & 3; return true; }
    __device__ __forceinline__ void a_ready(const Unit&) const {}
    __device__ __forceinline__ void done(const Unit&) const {}
};
template <class Epi, class Sched, bool ALIGN_EPI = false, bool SP2 = false>
__device__ __forceinline__ void gemm_phase(PG8_LAS unsigned char* lds, const Gemm g, const Sched& S, const Epi& E) {
    int tid_l = threadIdx.x; asm volatile("" : "+v"(tid_l)); const int tid = tid_l, wid = __builtin_amdgcn_readfirstlane(tid >> 6), lane = tid & 63, wr = wid >> 2, wc = wid & 3, fr = lane & 15, fq = lane >> 4;
    const int K = g.K, nt = K / BK;
    unsigned voffA[2], voffB[2];
#pragma unroll
    for (int i = 0; i < 2; ++i) { int R, C; stage_rc(tid * 16 + i * 8192, R, C); const int Rb = Epi::PERM ? ((R & ~31) + perm32(R & 31)) : R;
        voffA[i] = (unsigned)(R * K + C) * 2u; voffB[i] = (unsigned)(Rb * K + C) * 2u; }
    const size_t kstep = (size_t)(BK * 2);
    const size_t hstep = (size_t)HALF * K * 2;
    const size_t tstep = 2 * hstep;
    const unsigned ldsw = (unsigned)wid * 1024u;
    const int aoff = lds_byte(wr * 64 + fr, fq * 8), boff = lds_byte(wc * 32 + fr, fq * 8);
#define PG8_SA(b, h) (((b) * 2 + (h)) * HTB)
#define PG8_SB(b, h) ((4 + (b) * 2 + (h)) * HTB)
#define PG8_STAGE(bufoff, gbase, voff) do { _Pragma("unroll") for (int _i = 0; _i < 2; ++_i) \
        __builtin_amdgcn_global_load_lds((const unsigned*)((const char*)(gbase) + (voff)[_i]), (PG8_LAS unsigned*)(lds + (bufoff) + ldsw + _i * 8192), 16, 0, 0); } while (0)
#define PG8_LDA(dst, b, h) do { _Pragma("unroll") for (int m = 0; m < 4; ++m) _Pragma("unroll") for (int k = 0; k < 2; ++k) dst[m][k] = *(const PG8_LAS bf16x8*)(lds + PG8_SA(b, h) + aoff + m * 2048 + k * 1024); } while (0)
#define PG8_LDB(dst, b, h) do { _Pragma("unroll") for (int n = 0; n < 2; ++n) _Pragma("unroll") for (int k = 0; k < 2; ++k) dst[n][k] = *(const PG8_LAS bf16x8*)(lds + PG8_SB(b, h) + boff + n * 2048 + k * 1024); } while (0)
#define PG8_MMA(ai, bj, At, Bt) do { __builtin_amdgcn_s_setprio(1); _Pragma("unroll") for (int m = 0; m < 4; ++m) _Pragma("unroll") for (int n = 0; n < 2; ++n) _Pragma("unroll") for (int k = 0; k < 2; ++k) \
        acc[ai][bj][m][n] = __builtin_amdgcn_mfma_f32_16x16x32_bf16(Bt[n][k], At[m][k], acc[ai][bj][m][n], 0, 0, 0); __builtin_amdgcn_s_setprio(0); } while (0)
#define PG8_WAIT_V(n) asm volatile("s_waitcnt vmcnt(" #n ")" ::: "memory")
#define PG8_WAIT_L(n) asm volatile("s_waitcnt lgkmcnt(" #n ")" ::: "memory")
#define PG8_BAR __builtin_amdgcn_s_barrier()
#define PG8_SCHED __builtin_amdgcn_sched_barrier(0)
    Unit cur, nxt; int ui = 0;
    if (!S.next(0, cur)) return;
    f32x4 acc[2][2][4][2];
#pragma unroll
    for (int a = 0; a < 2; ++a)
#pragma unroll
        for (int b = 0; b < 2; ++b)
#pragma unroll
            for (int m = 0; m < 4; ++m)
#pragma unroll
                for (int n = 0; n < 2; ++n) acc[a][b][m][n] = (f32x4){0.f, 0.f, 0.f, 0.f};
    bf16x8 At[4][2], B0[2][2], B1[2][2];
    const char* cA = (const char*)g.A + (size_t)cur.pm * tstep; const char* cB = (const char*)g.Bt + (size_t)cur.pn * tstep;
    S.a_ready(cur);
    if constexpr (SP2) {
        PG8_STAGE(PG8_SB(0, 0), cB, voffB); PG8_STAGE(PG8_SB(0, 1), cB + hstep, voffB); PG8_STAGE(PG8_SA(0, 0), cA, voffA); PG8_STAGE(PG8_SA(0, 1), cA + hstep, voffA);
        if (wr == 1) PG8_BAR;
        PG8_WAIT_V(2); PG8_BAR;
        PG8_STAGE(PG8_SB(1, 0), cB + kstep, voffB); PG8_STAGE(PG8_SA(1, 0), cA + kstep, voffA); PG8_STAGE(PG8_SB(1, 1), cB + hstep + kstep, voffB);
        PG8_WAIT_V(6); PG8_BAR;
    } else {
        PG8_STAGE(PG8_SB(0, 0), cB, voffB); PG8_STAGE(PG8_SA(0, 0), cA, voffA); PG8_STAGE(PG8_SB(0, 1), cB + hstep, voffB); PG8_STAGE(PG8_SA(0, 1), cA + hstep, voffA);
        if (wr == 1) PG8_BAR;
        PG8_WAIT_V(4); PG8_BAR;
        PG8_STAGE(PG8_SB(1, 0), cB + kstep, voffB); PG8_STAGE(PG8_SA(1, 0), cA + kstep, voffA); PG8_STAGE(PG8_SB(1, 1), cB + hstep + kstep, voffB);
        PG8_WAIT_V(6); PG8_BAR;
    }
    for (;;) {
        const bool has_next = S.next(ui + 1, nxt);
        const char* nA = has_next ? (const char*)g.A + (size_t)nxt.pm * tstep : cA; const char* nB = has_next ? (const char*)g.Bt + (size_t)nxt.pn * tstep : cB;
        for (int t = 0; t < nt; t += 2) {
            const bool last = (t == nt - 2);
            const char* a1 = cA + (size_t)(t + 1) * kstep;
            const char* a2 = last ? nA : cA + (size_t)(t + 2) * kstep; const char* b2 = last ? nB : cB + (size_t)(t + 2) * kstep;
            const char* a3 = a2 + kstep; const char* b3 = b2 + kstep;
            if (last && has_next) S.a_ready(nxt);
            if constexpr (SP2) {
            PG8_LDB(B0, 0, 0); PG8_LDB(B1, 0, 1); PG8_SCHED; PG8_LDA(At, 0, 0); PG8_STAGE(PG8_SA(1, 1), a1 + hstep, voffA);
            PG8_WAIT_V(8); PG8_WAIT_L(0); PG8_BAR; PG8_MMA(0, 0, At, B0); PG8_MMA(0, 1, At, B1); PG8_BAR; PG8_SCHED;
            PG8_LDA(At, 0, 1); PG8_STAGE(PG8_SB(0, 0), b2, voffB); PG8_STAGE(PG8_SB(0, 1), b2 + hstep, voffB); PG8_STAGE(PG8_SA(0, 0), a2, voffA);
            PG8_WAIT_V(8); PG8_WAIT_L(0); PG8_BAR; PG8_MMA(1, 0, At, B0); PG8_MMA(1, 1, At, B1); PG8_BAR; PG8_SCHED;
            PG8_LDB(B0, 1, 0); PG8_LDB(B1, 1, 1); PG8_SCHED; PG8_LDA(At, 1, 0); PG8_STAGE(PG8_SA(0, 1), a2 + hstep, voffA);
            PG8_WAIT_V(8); PG8_WAIT_L(0); PG8_BAR; PG8_MMA(0, 0, At, B0); PG8_MMA(0, 1, At, B1); PG8_BAR; PG8_SCHED;
            PG8_LDA(At, 1, 1); PG8_STAGE(PG8_SB(1, 0), b3, voffB); PG8_STAGE(PG8_SB(1, 1), b3 + hstep, voffB); PG8_STAGE(PG8_SA(1, 0), a3, voffA);
            PG8_WAIT_V(8); PG8_WAIT_L(0); PG8_BAR; PG8_MMA(1, 0, At, B0); PG8_MMA(1, 1, At, B1); PG8_BAR; PG8_SCHED;
            } else {
            PG8_LDB(B0, 0, 0); PG8_SCHED; PG8_LDA(At, 0, 0); PG8_STAGE(PG8_SA(1, 1), a1 + hstep, voffA);
            PG8_WAIT_L(8); PG8_BAR; PG8_WAIT_L(0); PG8_MMA(0, 0, At, B0); PG8_BAR; PG8_SCHED;
            PG8_LDB(B1, 0, 1); PG8_STAGE(PG8_SB(0, 0), b2, voffB);
            PG8_BAR; PG8_WAIT_L(0); PG8_MMA(0, 1, At, B1); PG8_BAR;
            PG8_LDA(At, 0, 1); PG8_STAGE(PG8_SA(0, 0), a2, voffA);
            PG8_BAR; PG8_WAIT_L(0); PG8_MMA(1, 0, At, B0); PG8_BAR; PG8_SCHED;
            PG8_STAGE(PG8_SB(0, 1), b2 + hstep, voffB);
            PG8_WAIT_V(6); PG8_BAR; PG8_MMA(1, 1, At, B1); PG8_BAR;
            PG8_LDB(B0, 1, 0); PG8_SCHED; PG8_LDA(At, 1, 0); PG8_STAGE(PG8_SA(0, 1), a2 + hstep, voffA);
            PG8_WAIT_L(8); PG8_BAR; PG8_WAIT_L(0); PG8_MMA(0, 0, At, B0); PG8_BAR; PG8_SCHED;
            PG8_LDB(B1, 1, 1); PG8_STAGE(PG8_SB(1, 0), b3, voffB);
            PG8_BAR; PG8_WAIT_L(0); PG8_MMA(0, 1, At, B1); PG8_BAR;
            PG8_LDA(At, 1, 1); PG8_STAGE(PG8_SA(1, 0), a3, voffA);
            PG8_BAR; PG8_WAIT_L(0); PG8_MMA(1, 0, At, B0); PG8_BAR; PG8_SCHED;
            PG8_STAGE(PG8_SB(1, 1), b3 + hstep, voffB);
            PG8_WAIT_V(6); PG8_BAR; PG8_MMA(1, 1, At, B1); PG8_BAR;
            }
        }
        if constexpr (ALIGN_EPI) { if (wr == 0) PG8_BAR; }
        if constexpr (!Epi::AFTER_DRAIN) { E(acc, cur, wr, wc, fr, fq); S.done(cur); }
        if (!has_next) break;
#pragma unroll
        for (int a = 0; a < 2; ++a)
#pragma unroll
            for (int b = 0; b < 2; ++b)
#pragma unroll
                for (int m = 0; m < 4; ++m)
#pragma unroll
                    for (int n = 0; n < 2; ++n) acc[a][b][m][n] = (f32x4){0.f, 0.f, 0.f, 0.f};
        cur = nxt; cA = nA; cB = nB; ++ui;
        if constexpr (ALIGN_EPI) { if (wr == 1) PG8_BAR; }
    }
    PG8_WAIT_V(0);
    if constexpr (!ALIGN_EPI) { if (wr == 0) PG8_BAR; }
    PG8_BAR;
    if constexpr (Epi::AFTER_DRAIN) { E.fused(acc, cur, wr, wc, fr, fq, lds, wid, lane); S.done(cur); }
#undef PG8_SA
#undef PG8_SB
#undef PG8_STAGE
#undef PG8_LDA
#undef PG8_LDB
#undef PG8_MMA
#undef PG8_WAIT_V
#undef PG8_WAIT_L
#undef PG8_BAR
#undef PG8_SCHED
}
}

namespace cg = cooperative_groups;
#define LAS __attribute__((address_space(3)))
typedef unsigned short bf16_t;
typedef short bf16x8 __attribute__((ext_vector_type(8)));
typedef short s16x4 __attribute__((ext_vector_type(4)));
typedef float f32x4 __attribute__((ext_vector_type(4)));
typedef float f32x16 __attribute__((ext_vector_type(16)));
typedef unsigned u32x4 __attribute__((ext_vector_type(4)));
typedef unsigned u32x2 __attribute__((ext_vector_type(2)));
typedef float f32x2_t __attribute__((ext_vector_type(2)));
typedef __bf16 bf16x2_t __attribute__((ext_vector_type(2)));

constexpr int NB = 2, SEQ = 8192, CTX = 256, DM = 1024, DFF = 2816, INW = 2560, NMODW = 9 * 1024;
constexpr int MLAT = NB * SEQ, MCTX = NB * CTX, MTOT = MLAT + MCTX;
constexpr float EPS = 1e-6f, LOG2E = 1.4426950408889634f;
constexpr int NWAVES = 8, NTHR = 512;
#ifndef REP_MIX
#define REP_MIX 1
#endif
#ifndef REP_DIFF
#define REP_DIFF 1
#endif
#ifndef REP_P0
#define REP_P0 1
#endif
#ifndef REP_GEMM
#define REP_GEMM 1
#endif
#ifndef EXTRA_SYNC
#define EXTRA_SYNC 0
#endif
constexpr int LDS_BYTES = 155648;
constexpr size_t MiB = 1u << 20;
constexpr size_t WS_CTL = 0, CTL_ZERO_BYTES = 16384;
constexpr int BAR_LDS_OFF = 151552;
constexpr int CW_UPCNT = 3584;
constexpr size_t WS_MODS = 1 * MiB;
constexpr size_t WS_CS = 2 * MiB;
constexpr size_t WS_XC = 4 * MiB;
constexpr size_t WS_W = 8 * MiB, W_LAYER = 40 * MiB;
constexpr size_t W1T_BYTES = (size_t)2 * DFF * DM * 2, W2T_BYTES = (size_t)DM * DFF * 2, WIN_BYTES = (size_t)INW * DM * 2, WOUT_BYTES = (size_t)DM * DM * 2;
constexpr size_t OFF_W2T = 2 * W1T_BYTES, OFF_WIN = OFF_W2T + 2 * W2T_BYTES, OFF_WOUT = OFF_WIN + WIN_BYTES;
static_assert(OFF_WOUT + WOUT_BYTES == W_LAYER, "weight map");
constexpr size_t WS_H = 88 * MiB;
constexpr size_t WS_Y = 121 * MiB;
constexpr size_t WS_HID = 187 * MiB;
constexpr size_t WS_END = 278 * MiB;

__device__ __forceinline__ unsigned f2bf(float f) { unsigned u = __builtin_bit_cast(unsigned, f); return (u + 0x7fffu + ((u >> 16) & 1u)) >> 16; }
__device__ __forceinline__ unsigned pk2(float lo, float hi) { f32x2_t v = {lo, hi}; bf16x2_t b = __builtin_convertvector(v, bf16x2_t); return __builtin_bit_cast(unsigned, b); }
__device__ __forceinline__ float bf2f(bf16_t v) { return __builtin_bit_cast(float, (unsigned)v << 16); }
__device__ __forceinline__ float wave_sum(float v) {
#pragma unroll
    for (int o = 1; o < 64; o <<= 1) v += __shfl_xor(v, o);
    return v;
}
#define LDS_WAIT() asm volatile("s_waitcnt lgkmcnt(0)" ::: "memory")

struct Args { const float* in[16]; float* out; unsigned char* ws; };

#define XB_TMO      128
#define XB_XCNT(j)  (256  + 64 * (j))
#define XB_XSUB(j)  (1280 + 64 * (j))
#define XB_XGEN(j)  (2304 + 64 * (j))
#define XB_TOP      3328
#define XB_TOPGEN   3392
#define XCD_BAR_WORDS 3456
#define XB_SPIN_CAP (1u << 18)

__device__ __forceinline__ unsigned xb_ld(unsigned* p)              { return __hip_atomic_load(p, __ATOMIC_RELAXED, __HIP_MEMORY_SCOPE_AGENT); }
__device__ __forceinline__ unsigned xb_add(unsigned* p, unsigned v) { return __hip_atomic_fetch_add(p, v, __ATOMIC_RELAXED, __HIP_MEMORY_SCOPE_AGENT); }
__device__ __forceinline__ unsigned xb_xcc_id() { return (unsigned)__builtin_amdgcn_s_getreg((3 << 11) | 20) & 0xFu; }
#define XB_SPIN(cond, bar) do { unsigned _sp = 0; while (cond) { __builtin_amdgcn_s_sleep(1); \
    if ((++_sp & 255u) == 0u) { if (xb_ld(&(bar)[XB_TMO])) break; if (_sp > XB_SPIN_CAP) { atomicAdd(&(bar)[XB_TMO], 1u); break; } } } } while (0)

struct XcdBarrier {
    unsigned* bar; unsigned x;
    volatile LAS unsigned* st;
};

__device__ __forceinline__ XcdBarrier xcd_barrier_post(unsigned* bar, volatile LAS unsigned* st) {
    XcdBarrier b; b.bar = bar; b.x = xb_xcc_id(); b.st = st;
    if (threadIdx.x == 0) (void)xb_add(&bar[XB_XCNT(b.x)], 1u);
    return b;
}
__device__ __forceinline__ void xcd_barrier_complete(unsigned* bar, unsigned x, unsigned& nloc, unsigned& nx) {
    const unsigned G = gridDim.x * gridDim.y * gridDim.z;
    unsigned sum, cnt, mine, sp = 0u;
    for (;;) {
        sum = 0u; cnt = 0u; mine = 0u;
#pragma unroll
        for (unsigned j = 0; j < 16; ++j) { const unsigned c = xb_ld(&bar[XB_XCNT(j)]); sum += c; cnt += (c > 0u) ? 1u : 0u; mine = (j == x) ? c : mine; }
        if (sum == G) break;
        __builtin_amdgcn_s_sleep(1);
        if ((++sp & 255u) == 0u) { if (xb_ld(&bar[XB_TMO])) break; if (sp > XB_SPIN_CAP) { atomicAdd(&bar[XB_TMO], 1u); break; } }
    }
    nloc = mine > 0u ? mine : 1u; nx = cnt > 0u ? cnt : 1u;
}

__device__ __forceinline__ void xcd_barrier(const XcdBarrier& b) {
    asm volatile("s_waitcnt vmcnt(0)" ::: "memory");
    __syncthreads();
    if (threadIdx.x == 0) {
        unsigned* bar = b.bar;
        __builtin_amdgcn_s_waitcnt(0);
        unsigned nloc = b.st[0], nx = b.st[1];
        if (nloc == 0u) { xcd_barrier_complete(bar, b.x, nloc, nx); b.st[0] = nloc; b.st[1] = nx; }
        const unsigned old = xb_add(&bar[XB_XSUB(b.x)], 1u);
        const unsigned gen = old / nloc;
        if (old + 1u == (gen + 1u) * nloc) {
            __builtin_amdgcn_fence(__ATOMIC_RELEASE, "agent");
            asm volatile("s_waitcnt vmcnt(0)" ::: "memory");
            const unsigned og = xb_add(&bar[XB_TOP], 1u);
            const unsigned tg = og / nx;
            if (og + 1u == (tg + 1u) * nx) xb_add(&bar[XB_TOPGEN], 1u);
            else XB_SPIN(xb_ld(&bar[XB_TOPGEN]) == tg, bar);
            __builtin_amdgcn_fence(__ATOMIC_ACQUIRE, "agent");
            xb_add(&bar[XB_XGEN(b.x)], 1u);
            asm volatile("s_waitcnt vmcnt(0)" ::: "memory");
        } else {
            XB_SPIN(xb_ld(&bar[XB_XGEN(b.x)]) == gen, bar);
            __builtin_amdgcn_fence(__ATOMIC_ACQUIRE, "agent");
            asm volatile("s_waitcnt vmcnt(0)" ::: "memory");
        }
    }
    __syncthreads();
}

struct P0Item { const float* src; bf16_t* dst; int N, K; float scale; };
__device__ __forceinline__ P0Item p0_resolve(int it, const float* ffn_w1, const float* ffn_w2, const float* w_in, const float* w_out, unsigned char* ws) {
    constexpr int I_W1 = 16 * 176, I_W2 = 44 * 32, I_IN = 16 * 80, I_OUT = 16 * 32, I_LAYER = 2 * I_W1 + 2 * I_W2 + I_IN + I_OUT;
    const int l = it / I_LAYER; int r = it % I_LAYER; unsigned char* wl = ws + WS_W + (size_t)l * W_LAYER;
    const float* W; bf16_t* WT; int K, N, kind, item;
    if (r < 2 * I_W1) { const int s = r / I_W1; W = ffn_w1 + (size_t)(l * 2 + s) * DM * 2 * DFF; K = DM; N = 2 * DFF; WT = (bf16_t*)(wl + s * W1T_BYTES); kind = 1; item = r % I_W1; }
    else if (r < 2 * I_W1 + 2 * I_W2) { r -= 2 * I_W1; const int s = r / I_W2; W = ffn_w2 + (size_t)(l * 2 + s) * DFF * DM; K = DFF; N = DM; WT = (bf16_t*)(wl + OFF_W2T + s * W2T_BYTES); kind = 0; item = r % I_W2; }
    else if (r < 2 * I_W1 + 2 * I_W2 + I_IN) { r -= 2 * I_W1 + 2 * I_W2; W = w_in + (size_t)l * DM * INW; K = DM; N = INW; WT = (bf16_t*)(wl + OFF_WIN); kind = 2; item = r; }
    else { r -= 2 * I_W1 + 2 * I_W2 + I_IN; W = w_out + (size_t)l * DM * DM; K = DM; N = DM; WT = (bf16_t*)(wl + OFF_WOUT); kind = 0; item = r; }
    const int nblk = N / 32, kb = item / nblk, nb = item % nblk, k0 = 64 * kb, n0 = 32 * nb;
    int d0 = n0; float scale = 1.0f;
    if (kind == 1) { const int half = n0 / DFF, j = n0 % DFF; d0 = (j / 128) * 256 + half * 128 + (j % 128); scale = half ? (1.0f / LOG2E) : LOG2E; }
    else if (kind == 2) { if (n0 < 256 || (n0 >= 1024 && n0 < 1536)) scale = 0.125f * LOG2E;
        if (n0 >= 1024 && n0 < 2048) { const int tile = n0 / 256, c = n0 % 256, vec = c / 64, half = (c % 64) / 32; d0 = tile * 256 + half * 128 + vec * 32; } }
    P0Item I; I.src = W + (size_t)k0 * N + n0; I.dst = WT + (size_t)d0 * K + k0; I.N = N; I.K = K; I.scale = scale; return I;
}
__device__ __forceinline__ void p0_load(const P0Item& I, float (&wv)[32], int lane) {
#pragma unroll
    for (int i = 0; i < 32; ++i) wv[i] = I.src[(size_t)(2 * i + (lane >> 5)) * I.N + (lane & 31)];
}
__device__ __forceinline__ void p0_store(const P0Item& I, const float (&wv)[32], LAS float* scr, int lane) {
#pragma unroll
    for (int i = 0; i < 32; ++i) scr[(2 * i + (lane >> 5)) * 33 + (lane & 31)] = wv[i] * I.scale;
    LDS_WAIT();
    const int c = lane & 7;
#pragma unroll
    for (int j = 0; j < 4; ++j) { const int n = (lane >> 3) + 8 * j; const LAS float* s = scr + (8 * c) * 33 + n;
        u32x4 o; o.x = pk2(s[0 * 33], s[1 * 33]); o.y = pk2(s[2 * 33], s[3 * 33]); o.z = pk2(s[4 * 33], s[5 * 33]); o.w = pk2(s[6 * 33], s[7 * 33]);
        *(u32x4*)(I.dst + (size_t)n * I.K + 8 * c) = o; }
    LDS_WAIT();
}

struct PrepP {
    const float* xlat; const float* xctx;
    float* olat; float* octx;
    const bf16_t* Y; const float* gate; const float* gpost; float resw; int has_y;
    const float* shift; const float* gpre; int has_h; bf16_t* H;
};
__device__ __forceinline__ void prep_phase(const PrepP p, int gw, int ngw, int lane) {
    asm volatile("" : "+v"(lane));
    constexpr int NR = 2;
    for (int r0 = gw; r0 < MTOT; r0 += NR * ngw) {
        int rr[NR]; bool ok[NR];
#pragma unroll
        for (int q = 0; q < NR; ++q) { ok[q] = (r0 + q * ngw) < MTOT; rr[q] = ok[q] ? r0 + q * ngw : r0; }
        f32x4 v[NR][4]; u32x2 yb[NR][4];
#pragma unroll
        for (int q = 0; q < NR; ++q) {
            const int r = rr[q]; const bool isc = r >= MLAT;
            const float* xs = isc ? p.xctx + (size_t)(r - MLAT) * DM : p.xlat + (size_t)r * DM;
#pragma unroll
            for (int j = 0; j < 4; ++j) v[q][j] = ((const f32x4*)xs)[lane + 64 * j];
            if (p.has_y) {
#pragma unroll
                for (int j = 0; j < 4; ++j) yb[q][j] = ((const u32x2*)(p.Y + (size_t)r * DM))[lane + 64 * j];
            }
        }
#pragma unroll
        for (int q = 0; q < NR; ++q) {
            const int r = rr[q]; const bool isc = r >= MLAT; const int b3 = isc ? 2 : (r >> 13);
            if (p.has_y) {
                f32x4 y[4]; float ss = 0.f;
#pragma unroll
                for (int j = 0; j < 4; ++j) { y[j] = (f32x4){__builtin_bit_cast(float, yb[q][j].x << 16), __builtin_bit_cast(float, yb[q][j].x & 0xffff0000u), __builtin_bit_cast(float, yb[q][j].y << 16), __builtin_bit_cast(float, yb[q][j].y & 0xffff0000u)};
                    ss += (y[j].x * y[j].x + y[j].y * y[j].y) + (y[j].z * y[j].z + y[j].w * y[j].w); }
                const float rstd = __builtin_amdgcn_rsqf(wave_sum(ss) * (1.f / DM) + EPS) * p.resw;
#pragma unroll
                for (int j = 0; j < 4; ++j) { const f32x4 g4 = ((const f32x4*)(p.gate + (size_t)b3 * NMODW))[lane + 64 * j], gp = ((const f32x4*)p.gpost)[lane + 64 * j]; v[q][j] += g4 * (y[j] * rstd * gp); }
                if (ok[q]) { float* xd = isc ? p.octx + (size_t)(r - MLAT) * DM : p.olat + (size_t)r * DM;
#pragma unroll
                    for (int j = 0; j < 4; ++j) ((f32x4*)xd)[lane + 64 * j] = v[q][j]; }
            }
            if (p.has_h) {
                float ss = 0.f;
#pragma unroll
                for (int j = 0; j < 4; ++j) ss += (v[q][j].x * v[q][j].x + v[q][j].y * v[q][j].y) + (v[q][j].z * v[q][j].z + v[q][j].w * v[q][j].w);
                const float rstd = __builtin_amdgcn_rsqf(wave_sum(ss) * (1.f / DM) + EPS);
#pragma unroll
                for (int j = 0; j < 4; ++j) {
                    const f32x4 gp = ((const f32x4*)p.gpre)[lane + 64 * j], sh = ((const f32x4*)(p.shift + (size_t)b3 * NMODW))[lane + 64 * j], sc = ((const f32x4*)(p.shift + 1024 + (size_t)b3 * NMODW))[lane + 64 * j];
                    const f32x4 hv = (v[q][j] * rstd * gp) * (sc + 1.0f) + sh;
                    u32x2 w; w.x = pk2(hv.x, hv.y); w.y = pk2(hv.z, hv.w);
                    if (ok[q]) ((u32x2*)(p.H + (size_t)r * DM))[lane + 64 * j] = w;
                }
            }
        }
    }
}

__device__ __forceinline__ f32x16 mfma32(bf16x8 a, bf16x8 b, f32x16 c) { return __builtin_amdgcn_mfma_f32_32x32x16_bf16(a, b, c, 0, 0, 0); }
__device__ __forceinline__ s16x4 tr_read(const LAS unsigned char* p) { return __builtin_bit_cast(s16x4, __builtin_amdgcn_ds_read_tr16_b64_v4i16((LAS s16x4*)p)); }
template <int NDT>
__device__ __forceinline__ void sm_step(f32x16& s, float& m, float& l, f32x16 (&o)[NDT], bf16x8& pa, bf16x8& pb) {
    f32x16 p; float ls = 0.f;
#pragma unroll
    for (int i = 0; i < 16; ++i) { p[i] = __builtin_amdgcn_exp2f(s[i] - m); ls += p[i]; }
    if (__any(!(ls < 1.0e6f))) {
        float tm = fmaxf(s[0], s[1]);
#pragma unroll
        for (int i = 2; i < 16; ++i) tm = fmaxf(tm, s[i]);
        tm = fmaxf(tm, __shfl_xor(tm, 32));
        const float mn = fmaxf(m, tm);
        const float alpha = __builtin_amdgcn_exp2f(m - mn);
        l *= alpha;
#pragma unroll
        for (int d = 0; d < NDT; ++d) o[d] = o[d] * alpha;
        m = mn; ls = 0.f;
#pragma unroll
        for (int i = 0; i < 16; ++i) { p[i] = __builtin_amdgcn_exp2f(s[i] - m); ls += p[i]; }
    }
    l += ls;
    u32x4 w0, w1;
    w0.x = pk2(p[0], p[1]); w0.y = pk2(p[2], p[3]); w0.z = pk2(p[4], p[5]); w0.w = pk2(p[6], p[7]);
    w1.x = pk2(p[8], p[9]); w1.y = pk2(p[10], p[11]); w1.z = pk2(p[12], p[13]); w1.w = pk2(p[14], p[15]);
    pa = __builtin_bit_cast(bf16x8, w0); pb = __builtin_bit_cast(bf16x8, w1);
}

namespace att {
constexpr int KSTR = 272, VSTR = 320;
constexpr int DK_BYTES = 64 * KSTR, DV_BYTES = 64 * VSTR, DSTAGE = DK_BYTES + DV_BYTES;
constexpr int NVSTR = 192, NV_BYTES = 32 * NVSTR;
constexpr int RPB_OFF = 88000; constexpr int POOL_WAVE_BYTES = 81 * 128;
constexpr int QLDS_OFF = 2 * DSTAGE, QSTR = 272, QWAVE = 32 * QSTR;
static_assert(QLDS_OFF + NWAVES * QWAVE <= 151552, "diff LDS map");
static_assert(2 * DSTAGE <= RPB_OFF && NWAVES * POOL_WAVE_BYTES <= RPB_OFF && RPB_OFF + 4 * 465 * 4 <= 151552, "attention LDS map");
}

__device__ __forceinline__ void diff_unit(LAS unsigned char* lds, const bf16_t* __restrict__ P, bf16_t* __restrict__ MIX, int b, int h, int ctxq, int qblk,
                                          float lam, float oml, const float* __restrict__ sg) {
    using namespace att;
    int tid_l = threadIdx.x; asm volatile("" : "+v"(tid_l));
    const int tid = tid_l, lane = tid & 63, wid = __builtin_amdgcn_readfirstlane(tid >> 6), r32 = lane & 31, hh = lane >> 5;
    const int qrow = (ctxq ? MLAT + b * CTX : b * SEQ + qblk * 256) + wid * 32 + r32;
    const bf16_t* qp = P + (size_t)qrow * INW + 1024 + h * 128 + 8 * hh;
    const LAS unsigned char* qa = lds + QLDS_OFF + wid * QWAVE + r32 * QSTR + hh * 16;
#pragma unroll
    for (int ks = 0; ks < 4; ++ks) { *(LAS bf16x8*)((LAS unsigned char*)qa + ks * 32) = *(const bf16x8*)(qp + 16 * ks); *(LAS bf16x8*)((LAS unsigned char*)qa + 128 + ks * 32) = *(const bf16x8*)(qp + 64 + 16 * ks); }
    const int t0 = ctxq ? 128 : 0, t1 = 132;
    const int srow = tid >> 4, sch = tid & 15;
    u32x4 kreg[2], vreg[2];
    const bf16_t* sbase = P + (size_t)srow * INW + h * 128 + sch * 8;
#define DIFF_LOADT(t) do { const int rb_ = ((t) < 128 ? b * SEQ + 64 * (t) : MLAT + b * CTX + 64 * ((t) - 128)); \
        _Pragma("unroll") for (int i_ = 0; i_ < 2; ++i_) { const bf16_t* src_ = sbase + (size_t)(rb_ + 32 * i_) * INW; kreg[i_] = *(const u32x4*)(src_ + 1536); vreg[i_] = *(const u32x4*)(src_ + 2048); } } while (0)
#define DIFF_STORET(s) do { _Pragma("unroll") for (int i_ = 0; i_ < 2; ++i_) { *(LAS u32x4*)(lds + (s) * DSTAGE + (srow + 32 * i_) * KSTR + sch * 16) = kreg[i_]; \
        *(LAS u32x4*)(lds + (s) * DSTAGE + DK_BYTES + (srow + 32 * i_) * VSTR + sch * 16) = vreg[i_]; } } while (0)
    DIFF_LOADT(t0); DIFF_STORET(0); if (t0 + 1 < t1) DIFF_LOADT(t0 + 1); __syncthreads();
    f32x16 o1[4], o2[4];
#pragma unroll
    for (int d = 0; d < 4; ++d) { o1[d] = f32x16{}; o2[d] = f32x16{}; }
    float m1 = -1e30f, l1 = 0.f, m2 = -1e30f, l2 = 0.f;
    for (int t = t0; t < t1; ++t) {
        const int s = (t - t0) & 1;
        if (t + 1 < t1) { DIFF_STORET(s ^ 1); if (t + 2 < t1) DIFF_LOADT(t + 2); }
        const LAS unsigned char* Kb = lds + s * DSTAGE; const LAS unsigned char* Vb = Kb + DK_BYTES;
#pragma unroll
        for (int sub = 0; sub < 2; ++sub) {
            const LAS unsigned char* ka = Kb + (sub * 32 + r32) * KSTR + hh * 16;
            const LAS unsigned char* va = Vb + (sub * 32 + 4 * hh + ((lane & 15) >> 2)) * VSTR + (16 * ((lane >> 4) & 1) + 4 * (lane & 3)) * 2;
            f32x16 s1 = f32x16{}, s2 = f32x16{};
#pragma unroll
            for (int kh = 0; kh < 2; ++kh) {
                const bf16x8 k1a = *(const LAS bf16x8*)(ka + kh * 64), k1b = *(const LAS bf16x8*)(ka + kh * 64 + 32), k2a = *(const LAS bf16x8*)(ka + 128 + kh * 64), k2b = *(const LAS bf16x8*)(ka + 128 + kh * 64 + 32);
                const bf16x8 q1a = *(const LAS bf16x8*)(qa + kh * 64), q1b = *(const LAS bf16x8*)(qa + kh * 64 + 32), q2a = *(const LAS bf16x8*)(qa + 128 + kh * 64), q2b = *(const LAS bf16x8*)(qa + 128 + kh * 64 + 32);
                __builtin_amdgcn_s_setprio(1); s1 = mfma32(k1a, q1a, s1); s2 = mfma32(k2a, q2a, s2); s1 = mfma32(k1b, q1b, s1); s2 = mfma32(k2b, q2b, s2); __builtin_amdgcn_s_setprio(0);
            }
#define DIFF_VFRAG(dt, k2) ({ const s16x4 lo_ = tr_read(va + (16 * (k2)) * VSTR + (dt) * 64), hi_ = tr_read(va + (16 * (k2) + 8) * VSTR + (dt) * 64); \
                (bf16x8){lo_[0], lo_[1], lo_[2], lo_[3], hi_[0], hi_[1], hi_[2], hi_[3]}; })
            bf16x8 vf0 = DIFF_VFRAG(0, 0), vf1 = DIFF_VFRAG(0, 1), vf2 = DIFF_VFRAG(1, 0), vf3 = DIFF_VFRAG(1, 1);
            __builtin_amdgcn_sched_barrier(0);
            bf16x8 p1a, p1b, p2a, p2b;
            sm_step<4>(s1, m1, l1, o1, p1a, p1b);
            sm_step<4>(s2, m2, l2, o2, p2a, p2b);
            __builtin_amdgcn_sched_barrier(0);
            bf16x8 vg0 = DIFF_VFRAG(2, 0), vg1 = DIFF_VFRAG(2, 1), vg2 = DIFF_VFRAG(3, 0), vg3 = DIFF_VFRAG(3, 1);
            __builtin_amdgcn_s_setprio(1);
            o1[0] = mfma32(vf0, p1a, o1[0]); o2[0] = mfma32(vf0, p2a, o2[0]); o1[1] = mfma32(vf2, p1a, o1[1]); o2[1] = mfma32(vf2, p2a, o2[1]);
            o1[0] = mfma32(vf1, p1b, o1[0]); o2[0] = mfma32(vf1, p2b, o2[0]); o1[1] = mfma32(vf3, p1b, o1[1]); o2[1] = mfma32(vf3, p2b, o2[1]);
            __builtin_amdgcn_sched_barrier(0);
            o1[2] = mfma32(vg0, p1a, o1[2]); o2[2] = mfma32(vg0, p2a, o2[2]); o1[3] = mfma32(vg2, p1a, o1[3]); o2[3] = mfma32(vg2, p2a, o2[3]);
            o1[2] = mfma32(vg1, p1b, o1[2]); o2[2] = mfma32(vg1, p2b, o2[2]); o1[3] = mfma32(vg3, p1b, o1[3]); o2[3] = mfma32(vg3, p2b, o2[3]);
            __builtin_amdgcn_s_setprio(0);
#undef DIFF_VFRAG
        }
        __syncthreads();
    }
#undef DIFF_LOADT
#undef DIFF_STORET
    l1 += __shfl_xor(l1, 32); l2 += __shfl_xor(l2, 32);
    const float i1 = 1.0f / l1, i2 = lam / l2;
    float ss = 0.f;
#pragma unroll
    for (int dt = 0; dt < 4; ++dt)
#pragma unroll
        for (int i = 0; i < 16; ++i) { const float v = o1[dt][i] * i1 - o2[dt][i] * i2; o1[dt][i] = v; ss += v * v; }
    ss += __shfl_xor(ss, 32);
    const float rstd = __builtin_amdgcn_rsqf(ss * (1.f / 128.f) + EPS) * oml;
    bf16_t* op = MIX + (size_t)qrow * DM + 512 + h * 128;
#pragma unroll
    for (int dt = 0; dt < 4; ++dt)
#pragma unroll
        for (int g4 = 0; g4 < 4; ++g4) {
            const int e0 = 32 * dt + 8 * g4 + 4 * hh; const f32x4 gv = *(const f32x4*)(sg + e0);
            u32x2 w; w.x = pk2(o1[dt][4 * g4 + 0] * rstd * gv.x, o1[dt][4 * g4 + 1] * rstd * gv.y); w.y = pk2(o1[dt][4 * g4 + 2] * rstd * gv.z, o1[dt][4 * g4 + 3] * rstd * gv.w);
            *(u32x2*)(op + e0) = w;
        }
}

__device__ __forceinline__ void na_block_unit(LAS unsigned char* lds, const LAS float* rpbs, const bf16_t* __restrict__ P, bf16_t* __restrict__ MIX, int b, int hp, int ctxq, int rpq) {
    using namespace att;
    int tid_l = threadIdx.x; asm volatile("" : "+v"(tid_l));
    const int tid = tid_l, lane = tid & 63, wid = __builtin_amdgcn_readfirstlane(tid >> 6), r32 = lane & 31, hh = lane >> 5;
    const int cbw = wid & 3, hsel = wid >> 2, h = hp * 2 + hsel;
    int qrow, nloc = 0, rs0 = 0, band0 = 0, qr = 0, qc = 0, wc0 = 0, rsq = 0;
    if (!ctxq) {
        const int r0 = 2 * rpq; qr = r0 + (r32 >> 4); qc = cbw * 16 + (r32 & 15); qrow = b * SEQ + qr * 64 + qc;
        band0 = min(max(cbw * 16 - 8, 0), 32); wc0 = min(max(qc - 8, 0), 48); rsq = min(max(qr - 4, 0), 120);
        rs0 = min(max(r0 - 4, 0), 120); const int rs1 = min(max(r0 - 3, 0), 120); nloc = rs1 - rs0 + 8;
    } else qrow = MLAT + b * CTX + rpq * 128 + cbw * 32 + r32;
    bf16x8 qf[4];
#pragma unroll
    for (int ks = 0; ks < 4; ++ks) qf[ks] = *(const bf16x8*)(P + (size_t)qrow * INW + h * 64 + 16 * ks + 8 * hh);
    const int nst = 4 + nloc;
    const int srow = tid >> 4, sch = tid & 15;
    const bf16_t* sbase = P + (size_t)srow * INW + hp * 128 + sch * 8;
    u32x4 kreg[2], vreg[2];
#define NA_LOAD(s) do { const int rb_ = (s) < 4 ? MLAT + b * CTX + 64 * (s) : b * SEQ + (rs0 + (s) - 4) * 64; \
        _Pragma("unroll") for (int i_ = 0; i_ < 2; ++i_) { const bf16_t* src_ = sbase + (size_t)(rb_ + 32 * i_) * INW; kreg[i_] = *(const u32x4*)(src_ + 256); vreg[i_] = *(const u32x4*)(src_ + 512); } } while (0)
#define NA_STORE(st) do { _Pragma("unroll") for (int i_ = 0; i_ < 2; ++i_) { \
        *(LAS u32x4*)(lds + (st) * DSTAGE + (srow + 32 * i_) * KSTR + sch * 16) = kreg[i_]; \
        *(LAS u32x4*)(lds + (st) * DSTAGE + DK_BYTES + (srow + 32 * i_) * VSTR + sch * 16) = vreg[i_]; } } while (0)
    NA_LOAD(0); NA_STORE(0); __syncthreads();
    f32x16 o[2]; o[0] = f32x16{}; o[1] = f32x16{};
    float m = -1e30f, l = 0.f;
    for (int s = 0; s < nst; ++s) {
        const int st = s & 1; const bool more = s + 1 < nst;
        if (more) NA_LOAD(s + 1);
        const LAS unsigned char* Kb = lds + st * DSTAGE; const LAS unsigned char* Vb = Kb + DK_BYTES;
        const bool loc = s >= 4; const int nsub = loc ? 1 : 2, kr = rs0 + s - 4;
        for (int sub = 0; sub < nsub; ++sub) {
            const int koff = loc ? band0 : 32 * sub;
            const LAS unsigned char* ka = Kb + (koff + r32) * KSTR + hsel * 128 + hh * 16;
            f32x16 sc = f32x16{};
#pragma unroll
            for (int ks = 0; ks < 4; ++ks) sc = mfma32(*(const LAS bf16x8*)(ka + ks * 32), qf[ks], sc);
            if (loc) {
                const bool rowok = (kr >= rsq) && (kr < rsq + 8); const int drow = kr - qr + 7;
#pragma unroll
                for (int i = 0; i < 16; ++i) { const int kc = band0 + (i & 3) + 8 * (i >> 2) + 4 * hh; const bool ok = rowok && (kc >= wc0) && (kc < wc0 + 16);
                    const int idx = ok ? (drow * 31 + kc - qc + 15) : 0; const float bias = rpbs[h * 465 + idx]; sc[i] = ok ? sc[i] + bias : -1e30f; }
            }
            bf16x8 pa, pb; sm_step<2>(sc, m, l, o, pa, pb);
            const LAS unsigned char* va = Vb + (koff + 4 * hh + ((lane & 15) >> 2)) * VSTR + hsel * 128 + (16 * ((lane >> 4) & 1) + 4 * (lane & 3)) * 2;
#pragma unroll
            for (int dt = 0; dt < 2; ++dt)
#pragma unroll
                for (int k2 = 0; k2 < 2; ++k2) {
                    const s16x4 lo = tr_read(va + (16 * k2) * VSTR + dt * 64), hi = tr_read(va + (16 * k2 + 8) * VSTR + dt * 64);
                    const bf16x8 vf = {lo[0], lo[1], lo[2], lo[3], hi[0], hi[1], hi[2], hi[3]};
                    o[dt] = mfma32(vf, k2 ? pb : pa, o[dt]);
                }
        }
        if (more) NA_STORE(st ^ 1);
        __syncthreads();
    }
#undef NA_LOAD
#undef NA_STORE
    l += __shfl_xor(l, 32);
    const float inv = 1.0f / l;
    bf16_t* op = MIX + (size_t)qrow * DM + h * 64;
#pragma unroll
    for (int dt = 0; dt < 2; ++dt)
#pragma unroll
        for (int g4 = 0; g4 < 4; ++g4) {
            const int e0 = 32 * dt + 8 * g4 + 4 * hh;
            u32x2 w; w.x = pk2(o[dt][4 * g4 + 0] * inv, o[dt][4 * g4 + 1] * inv); w.y = pk2(o[dt][4 * g4 + 2] * inv, o[dt][4 * g4 + 3] * inv);
            *(u32x2*)(op + e0) = w;
        }
}

__device__ __forceinline__ void pool_unit(LAS unsigned char* wl, const bf16_t* __restrict__ P, bf16_t* __restrict__ MIX, const float* __restrict__ pw, const float* __restrict__ pscale, int uid, int lane) {
    asm volatile("" : "+v"(lane));
    const int g = uid & 3, sb = uid >> 2, halfw = 1 << g, r32 = lane & 31, hh = lane >> 5;
    int rowbase, L, T0;
    if (sb < 256) { rowbase = (sb >> 7) * SEQ; L = SEQ; T0 = (sb & 127) * 64; } else { const int s2 = sb - 256; rowbase = MLAT + (s2 >> 2) * CTX; L = CTX; T0 = (s2 & 3) * 64; }
#pragma unroll
    for (int i = 0; i < 10; ++i) { const int c = lane + 64 * i, row = c >> 3, ch = c & 7, tt = T0 - 8 + row;
        u32x4 v = (u32x4){0u, 0u, 0u, 0u};
        if (tt >= 0 && tt < L) v = *(const u32x4*)(P + (size_t)(rowbase + tt) * INW + 768 + g * 64 + ch * 8);
        *(LAS u32x4*)(wl + 128 + row * 128 + ch * 16) = v; }
    bf16x8 wf[2][4];
#pragma unroll
    for (int dt = 0; dt < 2; ++dt)
#pragma unroll
        for (int ks = 0; ks < 4; ++ks) { const float* wp = pw + (size_t)(g * 64 + 16 * ks + 8 * hh) * 64 + 32 * dt + r32;
            u32x4 w4; w4.x = pk2(wp[0], wp[64]); w4.y = pk2(wp[128], wp[192]); w4.z = pk2(wp[256], wp[320]); w4.w = pk2(wp[384], wp[448]); wf[dt][ks] = __builtin_bit_cast(bf16x8, w4); }
    LDS_WAIT();
    const LAS bf16_t* wl16 = (const LAS bf16_t*)(wl + 128) + lane;
    LAS bf16_t* pl = (LAS bf16_t*)wl;
#pragma unroll 4
    for (int tt = 0; tt < 64; ++tt) {
        const int t = T0 + tt, cnt = min(t + halfw, L) - max(t - halfw, 0);
        float sum = 0.f;
#pragma unroll
        for (int j = 0; j < 16; ++j) { const float v = bf2f(wl16[(tt + j) * 64]); sum += (j >= 8 - halfw && j < 8 + halfw) ? v : 0.f; }
        const float pooled = sum * __builtin_amdgcn_rcpf((float)cnt) - bf2f(wl16[(tt + 8) * 64]);
        pl[tt * 64 + lane] = (bf16_t)f2bf(pooled);
    }
    LDS_WAIT();
    const float scl0 = pscale[g * 64 + r32], scl1 = pscale[g * 64 + 32 + r32];
#pragma unroll
    for (int th = 0; th < 2; ++th) {
        f32x16 acc0 = f32x16{}, acc1 = f32x16{};
#pragma unroll
        for (int ks = 0; ks < 4; ++ks) { const bf16x8 af = *(const LAS bf16x8*)((const LAS unsigned char*)pl + (32 * th + r32) * 128 + (16 * ks + 8 * hh) * 2);
            acc0 = mfma32(af, wf[0][ks], acc0); acc1 = mfma32(af, wf[1][ks], acc1); }
        bf16_t* op = MIX + (size_t)(rowbase + T0 + 32 * th) * DM + 256 + g * 64 + r32;
#pragma unroll
        for (int i = 0; i < 16; ++i) { const int row = (i & 3) + 8 * (i >> 2) + 4 * hh; op[(size_t)row * DM] = (bf16_t)f2bf(acc0[i] * scl0); op[(size_t)row * DM + 32] = (bf16_t)f2bf(acc1[i] * scl1); }
    }
    LDS_WAIT();
}

typedef const __attribute__((address_space(4))) Args* ArgP;
__device__ __forceinline__ ArgP argp() { ArgP p = (ArgP)__builtin_amdgcn_kernarg_segment_ptr(); asm volatile("" : "+s"(p)); return p; }
#define WSP(A_, off) ((A_)->ws + (off))

__global__ void __launch_bounds__(NTHR, 2) mk_fwd(Args a_unused) {
    extern __shared__ __attribute__((aligned(16))) unsigned char lds_raw[];
    cg::grid_group grid = cg::this_grid();
    LAS unsigned char* lds = (LAS unsigned char*)lds_raw;
    const int G = gridDim.x, ngw = G * NWAVES;
    volatile LAS unsigned* bar_st = (volatile LAS unsigned*)(lds + BAR_LDS_OFF);
    if (threadIdx.x < 2) bar_st[threadIdx.x] = 0u;
    __syncthreads();
    const XcdBarrier bar = xcd_barrier_post((unsigned*)WSP(argp(), WS_CTL), bar_st);
#define GRID_BAR() xcd_barrier(bar)

    {
        ArgP A = argp();
        int tid_v = threadIdx.x; asm volatile("" : "+v"(tid_v));
        const int tid = tid_v, lane = tid & 63, wid = __builtin_amdgcn_readfirstlane(tid >> 6), gw = blockIdx.x * NWAVES + wid;
        const float* in_c = A->in[1]; const float* in_cctx = A->in[3]; const float* w_ada = A->in[4]; const float* b_ada = A->in[5];
        float* MODS = (float*)WSP(A, WS_MODS); float* CS = (float*)WSP(A, WS_CS);
        LAS float* sl = (LAS float*)lds; LAS float* red = sl + 3072;
        for (int i = tid; i < 3072; i += NTHR) { const int r = i >> 10, k = i & 1023; const float cv = r < 2 ? in_c[r * 1024 + k] : in_cctx[k]; sl[i] = cv / (1.0f + __expf(-cv)); }
        __syncthreads();
        for (int item = blockIdx.x; item < 288; item += G) {
            const int l = item / 144, n0 = (item % 144) * 64;
            const float* W = w_ada + (size_t)l * 1024 * NMODW + n0 + lane;
            float a0 = 0.f, a1 = 0.f, a2 = 0.f;
#pragma unroll 32
            for (int kk = 0; kk < 128; ++kk) { const int k = wid * 128 + kk; const float wv = W[(size_t)k * NMODW]; a0 = fmaf(sl[k], wv, a0); a1 = fmaf(sl[1024 + k], wv, a1); a2 = fmaf(sl[2048 + k], wv, a2); }
            red[(wid * 3 + 0) * 64 + lane] = a0; red[(wid * 3 + 1) * 64 + lane] = a1; red[(wid * 3 + 2) * 64 + lane] = a2;
            __syncthreads();
            if (tid < 192) { const int r = tid >> 6; float s = 0.f;
#pragma unroll
                for (int w8 = 0; w8 < 8; ++w8) s += red[(w8 * 3 + r) * 64 + lane];
                MODS[(size_t)(l * 3 + r) * NMODW + n0 + lane] = s + b_ada[l * NMODW + n0 + lane]; }
            __syncthreads();
        }
        for (int i = blockIdx.x * NTHR + tid; i < SEQ * 32; i += G * NTHR) {
            const int t = i >> 5, f = i & 31; const float pos = (float)(f < 16 ? (t >> 6) : (t & 63));
            const float inv = __builtin_amdgcn_exp2f(-(float)(f & 15) * 0.8304820237218406f);
            const float rev = pos * inv * 0.15915494309189535f;
            CS[t * 64 + f] = __builtin_amdgcn_cosf(rev); CS[t * 64 + 32 + f] = __builtin_amdgcn_sinf(rev);
        }
        __syncthreads();
        LAS float* scr = (LAS float*)(lds + wid * 16384);
        const float* ffn_w1 = A->in[7]; const float* ffn_w2 = A->in[8]; const float* w_in = A->in[9]; const float* w_out = A->in[10]; unsigned char* ws = A->ws;
        constexpr int N_ITEMS = 2 * (2 * 16 * 176 + 2 * 44 * 32 + 16 * 80 + 16 * 32);
        float wa[32], wb[32];
        int it = gw;
        if (it < N_ITEMS) {
            P0Item Ia = p0_resolve(it, ffn_w1, ffn_w2, w_in, w_out, ws); p0_load(Ia, wa, lane);
            for (;;) {
                const int it1 = it + ngw; P0Item Ib = Ia;
                if (it1 < N_ITEMS) { Ib = p0_resolve(it1, ffn_w1, ffn_w2, w_in, w_out, ws); p0_load(Ib, wb, lane); }
                p0_store(Ia, wa, scr, lane);
                if (it1 >= N_ITEMS) break;
                const int it2 = it1 + ngw;
                if (it2 < N_ITEMS) { Ia = p0_resolve(it2, ffn_w1, ffn_w2, w_in, w_out, ws); p0_load(Ia, wa, lane); }
                p0_store(Ib, wb, scr, lane);
                if (it2 >= N_ITEMS) break;
                it = it2;
            }
        }
    }
    grid.sync();

    for (int l = 0; l < 2; ++l) {
        for (int sub = 0; sub < 3; ++sub) {
            {
                ArgP A = argp();
                int tid_v = threadIdx.x; asm volatile("" : "+v"(tid_v));
                const int lane = tid_v & 63, gw = blockIdx.x * NWAVES + __builtin_amdgcn_readfirstlane(tid_v >> 6);
                const float* norm_g = A->in[6]; const float* MODS = (const float*)WSP(A, WS_MODS); float* XC = (float*)WSP(A, WS_XC);
                PrepP p{};
                const bool first = (l == 0 && sub == 0), src_in = (l == 0 && sub <= 1);
                p.xlat = src_in ? A->in[0] : A->out; p.xctx = src_in ? A->in[2] : XC; p.olat = A->out; p.octx = XC;
                p.Y = (const bf16_t*)WSP(A, WS_Y); p.has_y = first ? 0 : 1;
                if (!first) {
                    const int pl = (sub == 0) ? l - 1 : l, ps = (sub == 0) ? 2 : sub - 1;
                    p.gate = MODS + (size_t)pl * 3 * NMODW + (3 * ps + 2) * 1024; p.gpost = norm_g + (size_t)pl * 6 * DM + (2 * ps + 1) * DM; p.resw = (ps == 1) ? 1.0f : 0.5f;
                }
                p.has_h = 1; p.shift = MODS + (size_t)l * 3 * NMODW + (3 * sub) * 1024; p.gpre = norm_g + (size_t)l * 6 * DM + (2 * sub) * DM; p.H = (bf16_t*)WSP(A, WS_H);
                prep_phase(p, gw, ngw, lane);
            }
            GRID_BAR();
            if (sub != 1) {
                const int s = sub >> 1;
                const bool with_ctx = !(l == 1 && sub == 2);
                if (with_ctx) {
                    ArgP A = argp(); const unsigned char* wl = WSP(A, WS_W + (size_t)l * W_LAYER);
                    unsigned* cnt = (unsigned*)WSP(A, WS_CTL) + CW_UPCNT + 64 * (l * 2 + s);
                    { pg8::Gemm g{(const bf16_t*)WSP(A, WS_H), (const bf16_t*)(wl + s * W1T_BYTES), MTOT, 2 * DFF, DM}; pg8::OrderUpCtxFirst S{(int)blockIdx.x, cnt};
                      pg8::EpiSwiglu E{(bf16_t*)WSP(A, WS_HID), DFF}; pg8::gemm_phase<pg8::EpiSwiglu, pg8::OrderUpCtxFirst, true, true>(lds, g, S, E); }
                    if (blockIdx.x >= 248) {
                        if (threadIdx.x == 0) { unsigned sp = 0; while (__hip_atomic_load(cnt, __ATOMIC_RELAXED, __HIP_MEMORY_SCOPE_AGENT) < 352u && ++sp < (1u << 22)) __builtin_amdgcn_s_sleep(2); }
                        __syncthreads();
                        __builtin_amdgcn_fence(__ATOMIC_ACQUIRE, "agent"); asm volatile("s_waitcnt vmcnt(0)" ::: "memory");
                        __syncthreads();
                        ArgP A2 = argp(); const unsigned char* wl2 = WSP(A2, WS_W + (size_t)l * W_LAYER);
                        pg8::Gemm g{(const bf16_t*)WSP(A2, WS_HID), (const bf16_t*)(wl2 + OFF_W2T + s * W2T_BYTES), MTOT, DM, DFF}; pg8::OrderCtxTail S{(int)blockIdx.x};
                        pg8::EpiY E{(bf16_t*)WSP(A2, WS_Y), DM}; pg8::gemm_phase<pg8::EpiY, pg8::OrderCtxTail, true, true>(lds, g, S, E);
                    }
                } else {
                    ArgP A = argp(); const unsigned char* wl = WSP(A, WS_W + (size_t)l * W_LAYER);
                    pg8::Gemm g{(const bf16_t*)WSP(A, WS_H), (const bf16_t*)(wl + s * W1T_BYTES), MLAT, 2 * DFF, DM}; pg8::StaticOrder S; S.init(MLAT, 2 * DFF, G, (int)blockIdx.x);
                    pg8::EpiSwiglu E{(bf16_t*)WSP(A, WS_HID), DFF}; pg8::gemm_phase<pg8::EpiSwiglu, pg8::StaticOrder, true, true>(lds, g, S, E);
                }
                GRID_BAR();
                { ArgP A = argp(); const unsigned char* wl = WSP(A, WS_W + (size_t)l * W_LAYER);
                  pg8::Gemm g{(const bf16_t*)WSP(A, WS_HID), (const bf16_t*)(wl + OFF_W2T + s * W2T_BYTES), MLAT, DM, DFF}; pg8::StaticOrder S; S.init(MLAT, DM, G, (int)blockIdx.x);
                  pg8::EpiY E{(bf16_t*)WSP(A, WS_Y), DM}; for (int rep = 0; rep < REP_GEMM; ++rep) pg8::gemm_phase<pg8::EpiY, pg8::StaticOrder, true, true>(lds, g, S, E); }
                GRID_BAR();
            } else {
                { ArgP A = argp(); const unsigned char* wl = WSP(A, WS_W + (size_t)l * W_LAYER);
                  pg8::Gemm g{(const bf16_t*)WSP(A, WS_H), (const bf16_t*)(wl + OFF_WIN), MTOT, INW, DM}; pg8::StaticOrder S; S.init(MTOT, INW, G, (int)blockIdx.x);
                  pg8::EpiProj E{(bf16_t*)WSP(A, WS_HID), INW, (const float*)WSP(A, WS_CS), 0.125f * LOG2E}; for (int rep = 0; rep < REP_GEMM; ++rep) pg8::gemm_phase<pg8::EpiProj, pg8::StaticOrder, true, true>(lds, g, S, E); }
                GRID_BAR();
                {
                    ArgP A = argp();
                    int tid_v = threadIdx.x; asm volatile("" : "+v"(tid_v));
                    const int tid = tid_v, lane = tid & 63, wid = __builtin_amdgcn_readfirstlane(tid >> 6);
                    const bf16_t* PJ = (const bf16_t*)WSP(A, WS_HID); bf16_t* MIX = (bf16_t*)WSP(A, WS_H);
                    const float lam_init = __builtin_bit_cast(float, __builtin_amdgcn_readfirstlane(__builtin_bit_cast(int, (l == 0) ? 0.2f : 0.35550906759096926f)));
                    const float* dl = A->in[14] + l * 256; float d01 = 0.f, d23 = 0.f;
                    for (int i = 0; i < 64; ++i) { d01 = fmaf(dl[i], dl[64 + i], d01); d23 = fmaf(dl[128 + i], dl[192 + i], d23); }
                    const float lam = __expf(d01) - __expf(d23) + lam_init;
                    LAS float* rpbs = (LAS float*)(lds + att::RPB_OFF);
                    for (int rep = 0; rep < REP_MIX; ++rep) {
                    const int nun = (l == 0) ? 264 : 256;
                    for (int rd = 0; rd < REP_DIFF; ++rd)
                    for (int u = blockIdx.x; u < nun; u += G) {
                        if (u < 256) diff_unit(lds, PJ, MIX, (u & 7) >> 2, u & 3, 0, u >> 3, lam, 1.0f - lam_init, A->in[15] + l * 128);
                        else diff_unit(lds, PJ, MIX, ((u - 256) & 7) >> 2, (u - 256) & 3, 1, 0, lam, 1.0f - lam_init, A->in[15] + l * 128);
                    }
                    { int tid2 = threadIdx.x; asm volatile("" : "+v"(tid2)); const float* na_rpb = argp()->in[11]; for (int i = tid2; i < 4 * 465; i += NTHR) rpbs[i] = na_rpb[l * 4 * 465 + i] * LOG2E; }
                    __syncthreads();
                    for (int u = blockIdx.x; u < nun; u += G) {
                        if (u < 256) na_block_unit(lds, rpbs, PJ, MIX, (u >> 1) & 1, u & 1, 0, u >> 2);
                        else na_block_unit(lds, rpbs, PJ, MIX, ((u - 256) >> 1) & 1, (u - 256) & 1, 1, (u - 256) >> 2);
                    }
                    { int tid3 = threadIdx.x; asm volatile("" : "+v"(tid3)); const int lane3 = tid3 & 63, wid3 = __builtin_amdgcn_readfirstlane(tid3 >> 6);
                      for (int u = wid3 * G + (int)blockIdx.x; u < nun * 4; u += ngw)
                        pool_unit(lds + wid3 * att::POOL_WAVE_BYTES, PJ, MIX, argp()->in[12] + l * 4 * 64 * 64, argp()->in[13] + l * 256, u, lane3); }
                    __syncthreads();
                    }
                }
                GRID_BAR();
                for (int rep = 0; rep < EXTRA_SYNC; ++rep) GRID_BAR();
                { ArgP A = argp(); const unsigned char* wl = WSP(A, WS_W + (size_t)l * W_LAYER);
                  const int mrows = (l == 0) ? MTOT : MLAT;
                  pg8::Gemm g{(const bf16_t*)WSP(A, WS_H), (const bf16_t*)(wl + OFF_WOUT), mrows, DM, DM}; pg8::StaticOrder S; S.init(mrows, DM, G, (int)blockIdx.x);
                  pg8::EpiY E{(bf16_t*)WSP(A, WS_Y), DM}; for (int rep = 0; rep < REP_GEMM; ++rep) pg8::gemm_phase<pg8::EpiY, pg8::StaticOrder, true, true>(lds, g, S, E); }
                GRID_BAR();
            }
        }
    }
    {
        ArgP A = argp();
        int tid_v = threadIdx.x; asm volatile("" : "+v"(tid_v));
        const int lane = tid_v & 63, gw = blockIdx.x * NWAVES + __builtin_amdgcn_readfirstlane(tid_v >> 6);
        const float* MODS = (const float*)WSP(A, WS_MODS); float* XC = (float*)WSP(A, WS_XC);
        PrepP p{};
        p.xlat = A->out; p.xctx = XC; p.olat = A->out; p.octx = XC; p.Y = (const bf16_t*)WSP(A, WS_Y); p.has_y = 1;
        p.gate = MODS + (size_t)1 * 3 * NMODW + 8 * 1024; p.gpost = A->in[6] + (size_t)1 * 6 * DM + 5 * DM; p.resw = 0.5f; p.has_h = 0;
        prep_phase(p, gw, ngw, lane);
    }
}

extern "C" void kernel_launch(void* const* d_in, const int* in_sizes, int n_in, void* d_out, int out_size, void* d_ws, size_t ws_size, hipStream_t stream) {
    static int grid = 0;
    if (grid == 0) {
        if (n_in != 16 || out_size != MLAT * DM || ws_size < WS_END) { fprintf(stderr, "kernel_launch: unexpected shapes (n_in %d, out %d, ws %zu)\n", n_in, out_size, ws_size); grid = -1; return; }
        int dev = 0, cus = 0, per_cu = 0;
        if (hipGetDevice(&dev) != hipSuccess || hipDeviceGetAttribute(&cus, hipDeviceAttributeMultiprocessorCount, dev) != hipSuccess) { grid = -1; return; }
        if (hipFuncSetAttribute((const void*)mk_fwd, hipFuncAttributeMaxDynamicSharedMemorySize, LDS_BYTES) != hipSuccess) { fprintf(stderr, "kernel_launch: hipFuncSetAttribute failed\n"); grid = -1; return; }
        if (hipOccupancyMaxActiveBlocksPerMultiprocessor(&per_cu, (const void*)mk_fwd, NTHR, LDS_BYTES) != hipSuccess || per_cu < 1) { fprintf(stderr, "kernel_launch: occupancy query reports %d\n", per_cu); (void)hipGetLastError(); grid = -1; return; }
        grid = cus * per_cu;
        if (grid != 256) { fprintf(stderr, "kernel_launch: this build's unit orders need a 256-workgroup grid (got %d x %d)\n", cus, per_cu); grid = -1; return; }
    }
    if (grid < 0) return;
    if (hipMemsetAsync((char*)d_ws + WS_CTL, 0, CTL_ZERO_BYTES, stream) != hipSuccess) { fprintf(stderr, "kernel_launch: hipMemsetAsync failed\n"); return; }
    Args a{};
    for (int i = 0; i < 16; ++i) a.in[i] = (const float*)d_in[i];
    a.out = (float*)d_out; a.ws = (unsigned char*)d_ws;
    void* args[] = {&a};
    hipError_t e = hipLaunchCooperativeKernel((const void*)mk_fwd, dim3(grid), dim3(NTHR), args, LDS_BYTES, stream);
    if (e != hipSuccess) fprintf(stderr, "kernel_launch: cooperative launch failed: %s (grid %d)\n", hipGetErrorString(e), grid);
}
```

```cpp
#include <hip/hip_runtime.h>
#include <hip/hip_cooperative_groups.h>
#include <cstdio>
#include <cstdint>
namespace pg8 {
#define PG8_LAS __attribute__((address_space(3)))
typedef unsigned short bf16_t;
typedef short bf16x8 __attribute__((ext_vector_type(8)));
typedef float f32x4 __attribute__((ext_vector_type(4)));
typedef unsigned u32x4 __attribute__((ext_vector_type(4)));
constexpr int BM = 256, BK = 64, HALF = 128, HTB = HALF * BK * 2  , STAGE_BYTES = 8 * HTB, NXCD = 8, WGM = 8;

__host__ __device__ __forceinline__ int lds_byte(int r, int c) { const int st = (r >> 4) * 2 + (c >> 5), rr = r & 15, cc = c & 31, ob = rr * 64 + cc * 2; return st * 1024 + (ob ^ (((ob >> 9) & 1) << 5)); }
__host__ __device__ __forceinline__ void stage_rc(int b, int& R, int& C) { const int st = b / 1024, sb = b % 1024, swz = sb ^ (((sb >> 9) & 1) << 5); R = (st >> 1) * 16 + swz / 64; C = (st & 1) * 32 + (swz % 64) / 2; }
__host__ __device__ __forceinline__ int perm32(int rho) { const int n = rho >> 4, i = rho & 15; return 8 * (i >> 2) + 4 * n + (i & 3); }

struct Unit { int pm, pn; };
struct Gemm { const bf16_t* A; const bf16_t* Bt; int M, N, K; };

struct StaticOrder {
    int nM, nN, nwg, G, c;
    __host__ __device__ void init(int M, int N, int G_, int c_) { nM = M / BM; nN = N / BM; nwg = nM * nN; G = G_; c = c_; }
    __host__ __device__ bool next(int i, Unit& u) const {
        const long L = (long)i * G + c; if (L >= nwg) return false;
        int wgid = (int)L; { const int q = nwg / NXCD, r = nwg % NXCD, xcd = wgid % NXCD, off = wgid / NXCD; wgid = (xcd < r ? xcd * (q + 1) : r * (q + 1) + (xcd - r) * q) + off; }
        const int nig = WGM * nN, gid = wgid / nig, fm = gid * WGM, gsz = (nM - fm) < WGM ? (nM - fm) : WGM;
        u.pm = fm + ((wgid % nig) % gsz); u.pn = (wgid % nig) / gsz; return true;
    }
    __device__ __forceinline__ void a_ready(const Unit&) const {}
    __device__ __forceinline__ void done(const Unit&) const {}
};

typedef float f32x2 __attribute__((ext_vector_type(2)));
typedef __bf16 pg8_bf16x2 __attribute__((ext_vector_type(2)));
__device__ __forceinline__ unsigned cvt_pk_bf16(float lo, float hi) { f32x2 v = {lo, hi}; pg8_bf16x2 b = __builtin_convertvector(v, pg8_bf16x2); return __builtin_bit_cast(unsigned, b); }
typedef unsigned u32x2 __attribute__((ext_vector_type(2)));
struct EpiSwiglu {
    static constexpr bool PERM = true, AFTER_DRAIN = false;
    bf16_t* O; int ldc;
    __device__ __forceinline__ void operator()(const f32x4 (&acc)[2][2][4][2], const Unit& u, int wr, int wc, int fr, int fq) const {
        const int row0 = u.pm * BM + wr * 64 + fr, col0 = u.pn * 128 + wc * 32 + 8 * fq;
#pragma unroll
        for (int ai = 0; ai < 2; ++ai)
#pragma unroll
            for (int m = 0; m < 4; ++m) {
                bf16_t* rowp = O + (size_t)(row0 + ai * HALF + m * 16) * ldc + col0;
                float r[8];
#pragma unroll
                for (int n = 0; n < 2; ++n)
#pragma unroll
                    for (int e = 0; e < 4; ++e) {
                        const float a = acc[ai][0][m][n][e], b = acc[ai][1][m][n][e];
                        r[n * 4 + e] = a * b * __builtin_amdgcn_rcpf(1.0f + __builtin_amdgcn_exp2f(-a));
                    }
                u32x4 w; w.x = cvt_pk_bf16(r[0], r[1]); w.y = cvt_pk_bf16(r[2], r[3]); w.z = cvt_pk_bf16(r[4], r[5]); w.w = cvt_pk_bf16(r[6], r[7]);
                *(u32x4*)rowp = w;
            }
    }
};
struct EpiY {
    static constexpr bool PERM = true, AFTER_DRAIN = false;
    bf16_t* O; int ldc;
    __device__ __forceinline__ void operator()(const f32x4 (&acc)[2][2][4][2], const Unit& u, int wr, int wc, int fr, int fq) const {
        const int row0 = u.pm * BM + wr * 64 + fr, col0 = u.pn * BM + wc * 32 + 8 * fq;
#pragma unroll
        for (int ai = 0; ai < 2; ++ai)
#pragma unroll
            for (int m = 0; m < 4; ++m) {
                bf16_t* rowp = O + (size_t)(row0 + ai * HALF + m * 16) * ldc + col0;
#pragma unroll
                for (int bj = 0; bj < 2; ++bj) { const f32x4 v0 = acc[ai][bj][m][0], v1 = acc[ai][bj][m][1];
                    u32x4 w; w.x = cvt_pk_bf16(v0[0], v0[1]); w.y = cvt_pk_bf16(v0[2], v0[3]); w.z = cvt_pk_bf16(v1[0], v1[1]); w.w = cvt_pk_bf16(v1[2], v1[3]);
                    *(u32x4*)(rowp + bj * HALF) = w; }
            }
    }
};
struct EpiProj {
    static constexpr bool PERM = true, AFTER_DRAIN = false;
    bf16_t* O; int ldc; const float* cs; float qscale;
    __device__ __forceinline__ void operator()(const f32x4 (&acc)[2][2][4][2], const Unit& u, int wr, int wc, int fr, int fq) const {
        const int row0 = u.pm * BM + wr * 64 + fr;
        const bool rope = (u.pn >= 4 && u.pn < 8);
        if (!rope) {
            const int col0 = u.pn * BM + wc * 32 + 8 * fq;
#pragma unroll
            for (int ai = 0; ai < 2; ++ai)
#pragma unroll
                for (int m = 0; m < 4; ++m) {
                    bf16_t* rowp = O + (size_t)(row0 + ai * HALF + m * 16) * ldc + col0;
#pragma unroll
                    for (int bj = 0; bj < 2; ++bj) {
                        const f32x4 v0 = acc[ai][bj][m][0], v1 = acc[ai][bj][m][1];
                        u32x4 w; w.x = cvt_pk_bf16(v0[0], v0[1]); w.y = cvt_pk_bf16(v0[2], v0[3]); w.z = cvt_pk_bf16(v1[0], v1[1]); w.w = cvt_pk_bf16(v1[2], v1[3]);
                        *(u32x4*)(rowp + bj * HALF) = w;
                    }
                }
        } else {
            const bool lat = (u.pm < 64);
            const int col0 = u.pn * BM + wc * 64 + 8 * fq;
#pragma unroll
            for (int ai = 0; ai < 2; ++ai)
#pragma unroll
                for (int m = 0; m < 4; ++m) {
                    const int row = row0 + ai * HALF + m * 16;
                    bf16_t* rowp = O + (size_t)row * ldc + col0;
                    f32x4 c0 = (f32x4){1.f, 1.f, 1.f, 1.f}, c1 = c0, s0 = (f32x4){0.f, 0.f, 0.f, 0.f}, s1 = s0;
                    if (lat) { const float* cp = cs + (size_t)(row & 8191) * 64 + 8 * fq; c0 = *(const f32x4*)cp; c1 = *(const f32x4*)(cp + 4); s0 = *(const f32x4*)(cp + 32); s1 = *(const f32x4*)(cp + 36); }
                    const f32x4 a0 = acc[ai][0][m][0], a1 = acc[ai][0][m][1], b0 = acc[ai][1][m][0], b1 = acc[ai][1][m][1];
                    const f32x4 y10 = a0 * c0 - b0 * s0, y11 = a1 * c1 - b1 * s1, y20 = a0 * s0 + b0 * c0, y21 = a1 * s1 + b1 * c1;
                    u32x4 w; w.x = cvt_pk_bf16(y10[0], y10[1]); w.y = cvt_pk_bf16(y10[2], y10[3]); w.z = cvt_pk_bf16(y11[0], y11[1]); w.w = cvt_pk_bf16(y11[2], y11[3]);
                    *(u32x4*)rowp = w;
                    w.x = cvt_pk_bf16(y20[0], y20[1]); w.y = cvt_pk_bf16(y20[2], y20[3]); w.z = cvt_pk_bf16(y21[0], y21[1]); w.w = cvt_pk_bf16(y21[2], y21[3]);
                    *(u32x4*)(rowp + 32) = w;
                }
        }
    }
};
struct OrderUpCtxFirst {
    int c; unsigned* cnt;
    __device__ __forceinline__ bool next(int i, Unit& u) const {
        int L;
        if (c < 248) { L = i * 248 + c; if (L >= 1428) return false; } else { if (i >= 3) return false; L = 1428 + (c - 248) * 3 + i; }
        if (L < 44) { u.pm = 64 + L / 22; u.pn = L % 22; return true; }
        int wgid = L - 44; const int nwg = 64 * 22; { const int q = nwg / NXCD, r = nwg % NXCD, xcd = wgid % NXCD, off = wgid / NXCD; wgid = (xcd < r ? xcd * (q + 1) : r * (q + 1) + (xcd - r) * q) + off; }
        const int nig = WGM * 22; const int gid = wgid / nig, fm = gid * WGM;
        u.pm = fm + ((wgid % nig) % WGM); u.pn = (wgid % nig) / WGM; return true;
    }
    __device__ __forceinline__ void a_ready(const Unit&) const {}
    __device__ __forceinline__ void done(const Unit& u) const {
        if (u.pm >= 64) {
            asm volatile("s_waitcnt vmcnt(0)" ::: "memory");
            __builtin_amdgcn_fence(__ATOMIC_RELEASE, "agent");
            asm volatile("s_waitcnt vmcnt(0)" ::: "memory");
            if ((threadIdx.x & 63) == 0) __hip_atomic_fetch_add(cnt, 1u, __ATOMIC_RELAXED, __HIP_MEMORY_SCOPE_AGENT);
        }
    }
};
struct OrderCtxTail {
    int c;
    __device__ __forceinline__ bool next(int i, Unit& u) const { if (i > 0 || c < 248) return false; const int j = c - 248; u.pm = 64 + (j >> 2); u.pn = j & 3; return true; }
    __device__ __forceinline__ void a_ready(const Unit&) const {}
    __device__ __forceinline__ void done(const Unit&) const {}
};
template <class Epi, class Sched, bool ALIGN_EPI = false, bool SP2 = false>
__device__ __forceinline__ void gemm_phase(PG8_LAS unsigned char* lds, const Gemm g, const Sched& S, const Epi& E) {
    int tid_l = threadIdx.x; asm volatile("" : "+v"(tid_l)); const int tid = tid_l, wid = __builtin_amdgcn_readfirstlane(tid >> 6), lane = tid & 63, wr = wid >> 2, wc = wid & 3, fr = lane & 15, fq = lane >> 4;
    const int K = g.K, nt = K / BK;
    unsigned voffA[2], voffB[2];
#pragma unroll
    for (int i = 0; i < 2; ++i) { int R, C; stage_rc(tid * 16 + i * 8192, R, C); const int Rb = Epi::PERM ? ((R & ~31) + perm32(R & 31)) : R;
        voffA[i] = (unsigned)(R * K + C) * 2u; voffB[i] = (unsigned)(Rb * K + C) * 2u; }
    const size_t kstep = (size_t)(BK * 2);
    const size_t hstep = (size_t)HALF * K * 2;
    const size_t tstep = 2 * hstep;
    const unsigned ldsw = (unsigned)wid * 1024u;
    const int aoff = lds_byte(wr * 64 + fr, fq * 8), boff = lds_byte(wc * 32 + fr, fq * 8);
#define PG8_SA(b, h) (((b) * 2 + (h)) * HTB)
#define PG8_SB(b, h) ((4 + (b) * 2 + (h)) * HTB)
#define PG8_STAGE(bufoff, gbase, voff) do { _Pragma("unroll") for (int _i = 0; _i < 2; ++_i) \
        __builtin_amdgcn_global_load_lds((const unsigned*)((const char*)(gbase) + (voff)[_i]), (PG8_LAS unsigned*)(lds + (bufoff) + ldsw + _i * 8192), 16, 0, 0); } while (0)
#define PG8_LDA(dst, b, h) do { _Pragma("unroll") for (int m = 0; m < 4; ++m) _Pragma("unroll") for (int k = 0; k < 2; ++k) dst[m][k] = *(const PG8_LAS bf16x8*)(lds + PG8_SA(b, h) + aoff + m * 2048 + k * 1024); } while (0)
#define PG8_LDB(dst, b, h) do { _Pragma("unroll") for (int n = 0; n < 2; ++n) _Pragma("unroll") for (int k = 0; k < 2; ++k) dst[n][k] = *(const PG8_LAS bf16x8*)(lds + PG8_SB(b, h) + boff + n * 2048 + k * 1024); } while (0)
#define PG8_MMA(ai, bj, At, Bt) do { __builtin_amdgcn_s_setprio(1); _Pragma("unroll") for (int m = 0; m < 4; ++m) _Pragma("unroll") for (int n = 0; n < 2; ++n) _Pragma("unroll") for (int k = 0; k < 2; ++k) \
        acc[ai][bj][m][n] = __builtin_amdgcn_mfma_f32_16x16x32_bf16(Bt[n][k], At[m][k], acc[ai][bj][m][n], 0, 0, 0); __builtin_amdgcn_s_setprio(0); } while (0)
#define PG8_WAIT_V(n) asm volatile("s_waitcnt vmcnt(" #n ")" ::: "memory")
#define PG8_WAIT_L(n) asm volatile("s_waitcnt lgkmcnt(" #n ")" ::: "memory")
#define PG8_BAR __builtin_amdgcn_s_barrier()
#define PG8_SCHED __builtin_amdgcn_sched_barrier(0)
    Unit cur, nxt; int ui = 0;
    if (!S.next(0, cur)) return;
    f32x4 acc[2][2][4][2];
#pragma unroll
    for (int a = 0; a < 2; ++a)
#pragma unroll
        for (int b = 0; b < 2; ++b)
#pragma unroll
            for (int m = 0; m < 4; ++m)
#pragma unroll
                for (int n = 0; n < 2; ++n) acc[a][b][m][n] = (f32x4){0.f, 0.f, 0.f, 0.f};
    bf16x8 At[4][2], B0[2][2], B1[2][2];
    const char* cA = (const char*)g.A + (size_t)cur.pm * tstep; const char* cB = (const char*)g.Bt + (size_t)cur.pn * tstep;
    S.a_ready(cur);
    if constexpr (SP2) {
        PG8_STAGE(PG8_SB(0, 0), cB, voffB); PG8_STAGE(PG8_SB(0, 1), cB + hstep, voffB); PG8_STAGE(PG8_SA(0, 0), cA, voffA); PG8_STAGE(PG8_SA(0, 1), cA + hstep, voffA);
        if (wr == 1) PG8_BAR;
        PG8_WAIT_V(2); PG8_BAR;
        PG8_STAGE(PG8_SB(1, 0), cB + kstep, voffB); PG8_STAGE(PG8_SA(1, 0), cA + kstep, voffA); PG8_STAGE(PG8_SB(1, 1), cB + hstep + kstep, voffB);
        PG8_WAIT_V(6); PG8_BAR;
    } else {
        PG8_STAGE(PG8_SB(0, 0), cB, voffB); PG8_STAGE(PG8_SA(0, 0), cA, voffA); PG8_STAGE(PG8_SB(0, 1), cB + hstep, voffB); PG8_STAGE(PG8_SA(0, 1), cA + hstep, voffA);
        if (wr == 1) PG8_BAR;
        PG8_WAIT_V(4); PG8_BAR;
        PG8_STAGE(PG8_SB(1, 0), cB + kstep, voffB); PG8_STAGE(PG8_SA(1, 0), cA + kstep, voffA); PG8_STAGE(PG8_SB(1, 1), cB + hstep + kstep, voffB);
        PG8_WAIT_V(6); PG8_BAR;
    }
    for (;;) {
        const bool has_next = S.next(ui + 1, nxt);
        const char* nA = has_next ? (const char*)g.A + (size_t)nxt.pm * tstep : cA; const char* nB = has_next ? (const char*)g.Bt + (size_t)nxt.pn * tstep : cB;
        for (int t = 0; t < nt; t += 2) {
            const bool last = (t == nt - 2);
            const char* a1 = cA + (size_t)(t + 1) * kstep;
            const char* a2 = last ? nA : cA + (size_t)(t + 2) * kstep; const char* b2 = last ? nB : cB + (size_t)(t + 2) * kstep;
            const char* a3 = a2 + kstep; const char* b3 = b2 + kstep;
            if (last && has_next) S.a_ready(nxt);
            if constexpr (SP2) {
            PG8_LDB(B0, 0, 0); PG8_LDB(B1, 0, 1); PG8_SCHED; PG8_LDA(At, 0, 0); PG8_STAGE(PG8_SA(1, 1), a1 + hstep, voffA);
            PG8_WAIT_V(8); PG8_WAIT_L(0); PG8_BAR; PG8_MMA(0, 0, At, B0); PG8_MMA(0, 1, At, B1); PG8_BAR; PG8_SCHED;
            PG8_LDA(At, 0, 1); PG8_STAGE(PG8_SB(0, 0), b2, voffB); PG8_STAGE(PG8_SB(0, 1), b2 + hstep, voffB); PG8_STAGE(PG8_SA(0, 0), a2, voffA);
            PG8_WAIT_V(8); PG8_WAIT_L(0); PG8_BAR; PG8_MMA(1, 0, At, B0); PG8_MMA(1, 1, At, B1); PG8_BAR; PG8_SCHED;
            PG8_LDB(B0, 1, 0); PG8_LDB(B1, 1, 1); PG8_SCHED; PG8_LDA(At, 1, 0); PG8_STAGE(PG8_SA(0, 1), a2 + hstep, voffA);
            PG8_WAIT_V(8); PG8_WAIT_L(0); PG8_BAR; PG8_MMA(0, 0, At, B0); PG8_MMA(0, 1, At, B1); PG8_BAR; PG8_SCHED;
            PG8_LDA(At, 1, 1); PG8_STAGE(PG8_SB(1, 0), b3, voffB); PG8_STAGE(PG8_SB(1, 1), b3 + hstep, voffB); PG8_STAGE(PG8_SA(1, 0), a3, voffA);
            PG8_WAIT_V(8); PG8_WAIT_L(0); PG8_BAR; PG8_MMA(1, 0, At, B0); PG8_MMA(1, 1, At, B1); PG8_BAR; PG8_SCHED;
            } else {
            PG8_LDB(B0, 0, 0); PG8_SCHED; PG8_LDA(At, 0, 0); PG8_STAGE(PG8_SA(1, 1), a1 + hstep, voffA);
            PG8_WAIT_L(8); PG8_BAR; PG8_WAIT_L(0); PG8_MMA(0, 0, At, B0); PG8_BAR; PG8_SCHED;
            PG8_LDB(B1, 0, 1); PG8_STAGE(PG8_SB(0, 0), b2, voffB);
            PG8_BAR; PG8_WAIT_L(0); PG8_MMA(0, 1, At, B1); PG8_BAR;
            PG8_LDA(At, 0, 1); PG8_STAGE(PG8_SA(0, 0), a2, voffA);
            PG8_BAR; PG8_WAIT_L(0); PG8_MMA(1, 0, At, B0); PG8_BAR; PG8_SCHED;
            PG8_STAGE(PG8_SB(0, 1), b2 + hstep, voffB);
            PG8_WAIT_V(6); PG8_BAR; PG8_MMA(1, 1, At, B1); PG8_BAR;
            PG8_LDB(B0, 1, 0); PG8_SCHED; PG8_LDA(At, 1, 0); PG8_STAGE(PG8_SA(0, 1), a2 + hstep, voffA);
            PG8_WAIT_L(8); PG8_BAR; PG8_WAIT_L(0); PG8_MMA(0, 0, At, B0); PG8_BAR; PG8_SCHED;
            PG8_LDB(B1, 1, 1); PG8_STAGE(PG8_SB(1, 0), b3, voffB);
            PG8_BAR; PG8_WAIT_L(0); PG8_MMA(0, 1, At, B1); PG8_BAR;
            PG8_LDA(At, 1, 1); PG8_STAGE(PG8_SA(1, 0), a3, voffA);
            PG8_BAR; PG8_WAIT_L(0); PG8_MMA(1, 0, At, B0); PG8_BAR; PG8_SCHED;
            PG8_STAGE(PG8_SB(1, 1), b3 + hstep, voffB);
            PG8_WAIT_V(6); PG8_BAR; PG8_MMA(1, 1, At, B1); PG8_BAR;
            }
        }
        if constexpr (ALIGN_EPI) { if (wr == 0) PG8_BAR; }
        if constexpr (!Epi::AFTER_DRAIN) { E(acc, cur, wr, wc, fr, fq); S.done(cur); }
        if (!has_next) break;
#pragma unroll
        for (int a = 0; a < 2; ++a)
#pragma unroll
            for (int b = 0; b < 2; ++b)
#pragma unroll
                for (int m = 0; m < 4; ++m)
#pragma unroll
                    for (int n = 0; n < 2; ++n) acc[a][b][m][n] = (f32x4){0.f, 0.f, 0.f, 0.f};
        cur = nxt; cA = nA; cB = nB; ++ui;
        if constexpr (ALIGN_EPI) { if (wr == 1) PG8_BAR; }
    }
    PG8_WAIT_V(0);
    if constexpr (!ALIGN_EPI) { if (wr == 0) PG8_BAR; }
    PG8_BAR;
    if constexpr (Epi::AFTER_DRAIN) { E.fused(acc, cur, wr, wc, fr, fq, lds, wid, lane); S.done(cur); }
#undef PG8_SA
#undef PG8_SB
#undef PG8_STAGE
#undef PG8_LDA
#undef PG8_LDB
#undef PG8_MMA
#undef PG8_WAIT_V
#undef PG8_WAIT_L
#undef PG8_BAR
#undef PG8_SCHED
}
}

namespace cg = cooperative_groups;
#define LAS __attribute__((address_space(3)))
typedef unsigned short bf16_t;
typedef short bf16x8 __attribute__((ext_vector_type(8)));
typedef short s16x4 __attribute__((ext_vector_type(4)));
typedef float f32x4 __attribute__((ext_vector_type(4)));
typedef float f32x16 __attribute__((ext_vector_type(16)));
typedef unsigned u32x4 __attribute__((ext_vector_type(4)));
typedef unsigned u32x2 __attribute__((ext_vector_type(2)));
typedef float f32x2_t __attribute__((ext_vector_type(2)));
typedef __bf16 bf16x2_t __attribute__((ext_vector_type(2)));

constexpr int NB = 2, SEQ = 8192, CTX = 256, DM = 1024, DFF = 2816, INW = 2560, NMODW = 9 * 1024;
constexpr int MLAT = NB * SEQ, MCTX = NB * CTX, MTOT = MLAT + MCTX;
constexpr float EPS = 1e-6f, LOG2E = 1.4426950408889634f;
constexpr int NWAVES = 8, NTHR = 512;
#ifndef REP_MIX
#define REP_MIX 1
#endif
#ifndef REP_DIFF
#define REP_DIFF 1
#endif
#ifndef REP_P0
#define REP_P0 1
#endif
#ifndef REP_GEMM
#define REP_GEMM 1
#endif
#ifndef EXTRA_SYNC
#define EXTRA_SYNC 0
#endif
constexpr int LDS_BYTES = 155648;
constexpr size_t MiB = 1u << 20;
constexpr size_t WS_CTL = 0, CTL_ZERO_BYTES = 16384;
constexpr int BAR_LDS_OFF = 151552;
constexpr int CW_UPCNT = 3584;
constexpr size_t WS_MODS = 1 * MiB;
constexpr size_t WS_CS = 2 * MiB;
constexpr size_t WS_XC = 4 * MiB;
constexpr size_t WS_W = 8 * MiB, W_LAYER = 40 * MiB;
constexpr size_t W1T_BYTES = (size_t)2 * DFF * DM * 2, W2T_BYTES = (size_t)DM * DFF * 2, WIN_BYTES = (size_t)INW * DM * 2, WOUT_BYTES = (size_t)DM * DM * 2;
constexpr size_t OFF_W2T = 2 * W1T_BYTES, OFF_WIN = OFF_W2T + 2 * W2T_BYTES, OFF_WOUT = OFF_WIN + WIN_BYTES;
static_assert(OFF_WOUT + WOUT_BYTES == W_LAYER, "weight map");
constexpr size_t WS_H = 88 * MiB;
constexpr size_t WS_Y = 121 * MiB;
constexpr size_t WS_HID = 187 * MiB;
constexpr size_t WS_END = 278 * MiB;

__device__ __forceinline__ unsigned f2bf(float f) { unsigned u = __builtin_bit_cast(unsigned, f); return (u + 0x7fffu + ((u >> 16) & 1u)) >> 16; }
__device__ __forceinline__ unsigned pk2(float lo, float hi) { f32x2_t v = {lo, hi}; bf16x2_t b = __builtin_convertvector(v, bf16x2_t); return __builtin_bit_cast(unsigned, b); }
__device__ __forceinline__ float bf2f(bf16_t v) { return __builtin_bit_cast(float, (unsigned)v << 16); }
__device__ __forceinline__ float wave_sum(float v) {
#pragma unroll
    for (int o = 1; o < 64; o <<= 1) v += __shfl_xor(v, o);
    return v;
}
#define LDS_WAIT() asm volatile("s_waitcnt lgkmcnt(0)" ::: "memory")

struct Args { const float* in[16]; float* out; unsigned char* ws; };

#define XB_TMO      128
#define XB_XCNT(j)  (256  + 64 * (j))
#define XB_XSUB(j)  (1280 + 64 * (j))
#define XB_XGEN(j)  (2304 + 64 * (j))
#define XB_TOP      3328
#define XB_TOPGEN   3392
#define XCD_BAR_WORDS 3456
#define XB_SPIN_CAP (1u << 18)

__device__ __forceinline__ unsigned xb_ld(unsigned* p)              { return __hip_atomic_load(p, __ATOMIC_RELAXED, __HIP_MEMORY_SCOPE_AGENT); }
__device__ __forceinline__ unsigned xb_add(unsigned* p, unsigned v) { return __hip_atomic_fetch_add(p, v, __ATOMIC_RELAXED, __HIP_MEMORY_SCOPE_AGENT); }
__device__ __forceinline__ unsigned xb_xcc_id() { return (unsigned)__builtin_amdgcn_s_getreg((3 << 11) | 20) & 0xFu; }
#define XB_SPIN(cond, bar) do { unsigned _sp = 0; while (cond) { __builtin_amdgcn_s_sleep(1); \
    if ((++_sp & 255u) == 0u) { if (xb_ld(&(bar)[XB_TMO])) break; if (_sp > XB_SPIN_CAP) { atomicAdd(&(bar)[XB_TMO], 1u); break; } } } } while (0)

struct XcdBarrier {
    unsigned* bar; unsigned x;
    volatile LAS unsigned* st;
};

__device__ __forceinline__ XcdBarrier xcd_barrier_post(unsigned* bar, volatile LAS unsigned* st) {
    XcdBarrier b; b.bar = bar; b.x = xb_xcc_id(); b.st = st;
    if (threadIdx.x == 0) (void)xb_add(&bar[XB_XCNT(b.x)], 1u);
    return b;
}
__device__ __forceinline__ void xcd_barrier_complete(unsigned* bar, unsigned x, unsigned& nloc, unsigned& nx) {
    const unsigned G = gridDim.x * gridDim.y * gridDim.z;
    unsigned sum, cnt, mine, sp = 0u;
    for (;;) {
        sum = 0u; cnt = 0u; mine = 0u;
#pragma unroll
        for (unsigned j = 0; j < 16; ++j) { const unsigned c = xb_ld(&bar[XB_XCNT(j)]); sum += c; cnt += (c > 0u) ? 1u : 0u; mine = (j == x) ? c : mine; }
        if (sum == G) break;
        __builtin_amdgcn_s_sleep(1);
        if ((++sp & 255u) == 0u) { if (xb_ld(&bar[XB_TMO])) break; if (sp > XB_SPIN_CAP) { atomicAdd(&bar[XB_TMO], 1u); break; } }
    }
    nloc = mine > 0u ? mine : 1u; nx = cnt > 0u ? cnt : 1u;
}

__device__ __forceinline__ void xcd_barrier(const XcdBarrier& b) {
    asm volatile("s_waitcnt vmcnt(0)" ::: "memory");
    __syncthreads();
    if (threadIdx.x == 0) {
        unsigned* bar = b.bar;
        __builtin_amdgcn_s_waitcnt(0);
        unsigned nloc = b.st[0], nx = b.st[1];
        if (nloc == 0u) { xcd_barrier_complete(bar, b.x, nloc, nx); b.st[0] = nloc; b.st[1] = nx; }
        const unsigned old = xb_add(&bar[XB_XSUB(b.x)], 1u);
        const unsigned gen = old / nloc;
        if (old + 1u == (gen + 1u) * nloc) {
            __builtin_amdgcn_fence(__ATOMIC_RELEASE, "agent");
            asm volatile("s_waitcnt vmcnt(0)" ::: "memory");
            const unsigned og = xb_add(&bar[XB_TOP], 1u);
            const unsigned tg = og / nx;
            if (og + 1u == (tg + 1u) * nx) xb_add(&bar[XB_TOPGEN], 1u);
            else XB_SPIN(xb_ld(&bar[XB_TOPGEN]) == tg, bar);
            __builtin_amdgcn_fence(__ATOMIC_ACQUIRE, "agent");
            xb_add(&bar[XB_XGEN(b.x)], 1u);
            asm volatile("s_waitcnt vmcnt(0)" ::: "memory");
        } else {
            XB_SPIN(xb_ld(&bar[XB_XGEN(b.x)]) == gen, bar);
            __builtin_amdgcn_fence(__ATOMIC_ACQUIRE, "agent");
            asm volatile("s_waitcnt vmcnt(0)" ::: "memory");
        }
    }
    __syncthreads();
}

struct P0Item { const float* src; bf16_t* dst; int N, K; float scale; };
__device__ __forceinline__ P0Item p0_resolve(int it, const float* ffn_w1, const float* ffn_w2, const float* w_in, const float* w_out, unsigned char* ws) {
    constexpr int I_W1 = 16 * 176, I_W2 = 44 * 32, I_IN = 16 * 80, I_OUT = 16 * 32, I_LAYER = 2 * I_W1 + 2 * I_W2 + I_IN + I_OUT;
    const int l = it / I_LAYER; int r = it % I_LAYER; unsigned char* wl = ws + WS_W + (size_t)l * W_LAYER;
    const float* W; bf16_t* WT; int K, N, kind, item;
    if (r < 2 * I_W1) { const int s = r / I_W1; W = ffn_w1 + (size_t)(l * 2 + s) * DM * 2 * DFF; K = DM; N = 2 * DFF; WT = (bf16_t*)(wl + s * W1T_BYTES); kind = 1; item = r % I_W1; }
    else if (r < 2 * I_W1 + 2 * I_W2) { r -= 2 * I_W1; const int s = r / I_W2; W = ffn_w2 + (size_t)(l * 2 + s) * DFF * DM; K = DFF; N = DM; WT = (bf16_t*)(wl + OFF_W2T + s * W2T_BYTES); kind = 0; item = r % I_W2; }
    else if (r < 2 * I_W1 + 2 * I_W2 + I_IN) { r -= 2 * I_W1 + 2 * I_W2; W = w_in + (size_t)l * DM * INW; K = DM; N = INW; WT = (bf16_t*)(wl + OFF_WIN); kind = 2; item = r; }
    else { r -= 2 * I_W1 + 2 * I_W2 + I_IN; W = w_out + (size_t)l * DM * DM; K = DM; N = DM; WT = (bf16_t*)(wl + OFF_WOUT); kind = 0; item = r; }
    const int nblk = N / 32, kb = item / nblk, nb = item % nblk, k0 = 64 * kb, n0 = 32 * nb;
    int d0 = n0; float scale = 1.0f;
    if (kind == 1) { const int half = n0 / DFF, j = n0 % DFF; d0 = (j / 128) * 256 + half * 128 + (j % 128); scale = half ? (1.0f / LOG2E) : LOG2E; }
    else if (kind == 2) { if (n0 < 256 || (n0 >= 1024 && n0 < 1536)) scale = 0.125f * LOG2E;
        if (n0 >= 1024 && n0 < 2048) { const int tile = n0 / 256, c = n0 % 256, vec = c / 64, half = (c % 64) / 32; d0 = tile * 256 + half * 128 + vec * 32; } }
    P0Item I; I.src = W + (size_t)k0 * N + n0; I.dst = WT + (size_t)d0 * K + k0; I.N = N; I.K = K; I.scale = scale; return I;
}
__device__ __forceinline__ void p0_load(const P0Item& I, float (&wv)[32], int lane) {
#pragma unroll
    for (int i = 0; i < 32; ++i) wv[i] = I.src[(size_t)(2 * i + (lane >> 5)) * I.N + (lane & 31)];
}
__device__ __forceinline__ void p0_store(const P0Item& I, const float (&wv)[32], LAS float* scr, int lane) {
#pragma unroll
    for (int i = 0; i < 32; ++i) scr[(2 * i + (lane >> 5)) * 33 + (lane & 31)] = wv[i] * I.scale;
    LDS_WAIT();
    const int c = lane & 7;
#pragma unroll
    for (int j = 0; j < 4; ++j) { const int n = (lane >> 3) + 8 * j; const LAS float* s = scr + (8 * c) * 33 + n;
        u32x4 o; o.x = pk2(s[0 * 33], s[1 * 33]); o.y = pk2(s[2 * 33], s[3 * 33]); o.z = pk2(s[4 * 33], s[5 * 33]); o.w = pk2(s[6 * 33], s[7 * 33]);
        *(u32x4*)(I.dst + (size_t)n * I.K + 8 * c) = o; }
    LDS_WAIT();
}

struct PrepP {
    const float* xlat; const float* xctx;
    float* olat; float* octx;
    const bf16_t* Y; const float* gate; const float* gpost; float resw; int has_y;
    const float* shift; const float* gpre; int has_h; bf16_t* H;
};
__device__ __forceinline__ void prep_phase(const PrepP p, int gw, int ngw, int lane) {
    asm volatile("" : "+v"(lane));
    constexpr int NR = 2;
    for (int r0 = gw; r0 < MTOT; r0 += NR * ngw) {
        int rr[NR]; bool ok[NR];
#pragma unroll
        for (int q = 0; q < NR; ++q) { ok[q] = (r0 + q * ngw) < MTOT; rr[q] = ok[q] ? r0 + q * ngw : r0; }
        f32x4 v[NR][4]; u32x2 yb[NR][4];
#pragma unroll
        for (int q = 0; q < NR; ++q) {
            const int r = rr[q]; const bool isc = r >= MLAT;
            const float* xs = isc ? p.xctx + (size_t)(r - MLAT) * DM : p.xlat + (size_t)r * DM;
#pragma unroll
            for (int j = 0; j < 4; ++j) v[q][j] = ((const f32x4*)xs)[lane + 64 * j];
            if (p.has_y) {
#pragma unroll
                for (int j = 0; j < 4; ++j) yb[q][j] = ((const u32x2*)(p.Y + (size_t)r * DM))[lane + 64 * j];
            }
        }
#pragma unroll
        for (int q = 0; q < NR; ++q) {
            const int r = rr[q]; const bool isc = r >= MLAT; const int b3 = isc ? 2 : (r >> 13);
            if (p.has_y) {
                f32x4 y[4]; float ss = 0.f;
#pragma unroll
                for (int j = 0; j < 4; ++j) { y[j] = (f32x4){__builtin_bit_cast(float, yb[q][j].x << 16), __builtin_bit_cast(float, yb[q][j].x & 0xffff0000u), __builtin_bit_cast(float, yb[q][j].y << 16), __builtin_bit_cast(float, yb[q][j].y & 0xffff0000u)};
                    ss += (y[j].x * y[j].x + y[j].y * y[j].y) + (y[j].z * y[j].z + y[j].w * y[j].w); }
                const float rstd = __builtin_amdgcn_rsqf(wave_sum(ss) * (1.f / DM) + EPS);
#pragma unroll
                for (int j = 0; j < 4; ++j) { const f32x4 g4 = ((const f32x4*)(p.gate + (size_t)b3 * NMODW))[lane + 64 * j]; v[q][j] += g4 * (y[j] * rstd); }
                if (ok[q]) { float* xd = isc ? p.octx + (size_t)(r - MLAT) * DM : p.olat + (size_t)r * DM;
#pragma unroll
                    for (int j = 0; j < 4; ++j) ((f32x4*)xd)[lane + 64 * j] = v[q][j]; }
            }
            if (p.has_h) {
                float ss = 0.f;
#pragma unroll
                for (int j = 0; j < 4; ++j) ss += (v[q][j].x * v[q][j].x + v[q][j].y * v[q][j].y) + (v[q][j].z * v[q][j].z + v[q][j].w * v[q][j].w);
                const float rstd = __builtin_amdgcn_rsqf(wave_sum(ss) * (1.f / DM) + EPS);
#pragma unroll
                for (int j = 0; j < 4; ++j) {
                    const f32x4 sh = ((const f32x4*)(p.shift + (size_t)b3 * NMODW))[lane + 64 * j], sc = ((const f32x4*)(p.shift + 1024 + (size_t)b3 * NMODW))[lane + 64 * j];
                    const f32x4 hv = (v[q][j] * rstd) * sc + sh;
                    u32x2 w; w.x = pk2(hv.x, hv.y); w.y = pk2(hv.z, hv.w);
                    if (ok[q]) ((u32x2*)(p.H + (size_t)r * DM))[lane + 64 * j] = w;
                }
            }
        }
    }
}

__device__ __forceinline__ f32x16 mfma32(bf16x8 a, bf16x8 b, f32x16 c) { return __builtin_amdgcn_mfma_f32_32x32x16_bf16(a, b, c, 0, 0, 0); }
__device__ __forceinline__ s16x4 tr_read(const LAS unsigned char* p) { return __builtin_bit_cast(s16x4, __builtin_amdgcn_ds_read_tr16_b64_v4i16((LAS s16x4*)p)); }
template <int NDT>
__device__ __forceinline__ void sm_step(f32x16& s, float& m, float& l, f32x16 (&o)[NDT], bf16x8& pa, bf16x8& pb) {
    f32x16 p; float ls = 0.f;
#pragma unroll
    for (int i = 0; i < 16; ++i) { p[i] = __builtin_amdgcn_exp2f(s[i] - m); ls += p[i]; }
    if (__any(!(ls < 1.0e6f))) {
        float tm = fmaxf(s[0], s[1]);
#pragma unroll
        for (int i = 2; i < 16; ++i) tm = fmaxf(tm, s[i]);
        tm = fmaxf(tm, __shfl_xor(tm, 32));
        const float mn = fmaxf(m, tm);
        const float alpha = __builtin_amdgcn_exp2f(m - mn);
        l *= alpha;
#pragma unroll
        for (int d = 0; d < NDT; ++d) o[d] = o[d] * alpha;
        m = mn; ls = 0.f;
#pragma unroll
        for (int i = 0; i < 16; ++i) { p[i] = __builtin_amdgcn_exp2f(s[i] - m); ls += p[i]; }
    }
    l += ls;
    u32x4 w0, w1;
    w0.x = pk2(p[0], p[1]); w0.y = pk2(p[2], p[3]); w0.z = pk2(p[4], p[5]); w0.w = pk2(p[6], p[7]);
    w1.x = pk2(p[8], p[9]); w1.y = pk2(p[10], p[11]); w1.z = pk2(p[12], p[13]); w1.w = pk2(p[14], p[15]);
    pa = __builtin_bit_cast(bf16x8, w0); pb = __builtin_bit_cast(bf16x8, w1);
}

namespace att {
constexpr int KSTR = 272, VSTR = 320;
constexpr int DK_BYTES = 64 * KSTR, DV_BYTES = 64 * VSTR, DSTAGE = DK_BYTES + DV_BYTES;
constexpr int NVSTR = 192, NV_BYTES = 32 * NVSTR;
constexpr int RPB_OFF = 88000; constexpr int POOL_WAVE_BYTES = 81 * 128;
constexpr int QLDS_OFF = 2 * DSTAGE, QSTR = 272, QWAVE = 32 * QSTR;
static_assert(QLDS_OFF + NWAVES * QWAVE <= 151552, "diff LDS map");
static_assert(2 * DSTAGE <= RPB_OFF && NWAVES * POOL_WAVE_BYTES <= RPB_OFF && RPB_OFF + 4 * 465 * 4 <= 151552, "attention LDS map");
}

__device__ __forceinline__ void diff_unit(LAS unsigned char* lds, const bf16_t* __restrict__ P, bf16_t* __restrict__ MIX, int b, int h, int ctxq, int qblk,
                                          float lam, float oml, const float* __restrict__ sg) {
    using namespace att;
    int tid_l = threadIdx.x; asm volatile("" : "+v"(tid_l));
    const int tid = tid_l, lane = tid & 63, wid = __builtin_amdgcn_readfirstlane(tid >> 6), r32 = lane & 31, hh = lane >> 5;
    const int qrow = (ctxq ? MLAT + b * CTX : b * SEQ + qblk * 256) + wid * 32 + r32;
    const bf16_t* qp = P + (size_t)qrow * INW + 1024 + h * 128 + 8 * hh;
    const LAS unsigned char* qa = lds + QLDS_OFF + wid * QWAVE + r32 * QSTR + hh * 16;
#pragma unroll
    for (int ks = 0; ks < 4; ++ks) { *(LAS bf16x8*)((LAS unsigned char*)qa + ks * 32) = *(const bf16x8*)(qp + 16 * ks); *(LAS bf16x8*)((LAS unsigned char*)qa + 128 + ks * 32) = *(const bf16x8*)(qp + 64 + 16 * ks); }
    const int t0 = ctxq ? 128 : 0, t1 = 132;
    const int srow = tid >> 4, sch = tid & 15;
    u32x4 kreg[2], vreg[2];
    const bf16_t* sbase = P + (size_t)srow * INW + h * 128 + sch * 8;
#define DIFF_LOADT(t) do { const int rb_ = ((t) < 128 ? b * SEQ + 64 * (t) : MLAT + b * CTX + 64 * ((t) - 128)); \
        _Pragma("unroll") for (int i_ = 0; i_ < 2; ++i_) { const bf16_t* src_ = sbase + (size_t)(rb_ + 32 * i_) * INW; kreg[i_] = *(const u32x4*)(src_ + 1536); vreg[i_] = *(const u32x4*)(src_ + 2048); } } while (0)
#define DIFF_STORET(s) do { _Pragma("unroll") for (int i_ = 0; i_ < 2; ++i_) { *(LAS u32x4*)(lds + (s) * DSTAGE + (srow + 32 * i_) * KSTR + sch * 16) = kreg[i_]; \
        *(LAS u32x4*)(lds + (s) * DSTAGE + DK_BYTES + (srow + 32 * i_) * VSTR + sch * 16) = vreg[i_]; } } while (0)
    DIFF_LOADT(t0); DIFF_STORET(0); if (t0 + 1 < t1) DIFF_LOADT(t0 + 1); __syncthreads();
    f32x16 o1[4], o2[4];
#pragma unroll
    for (int d = 0; d < 4; ++d) { o1[d] = f32x16{}; o2[d] = f32x16{}; }
    float m1 = -1e30f, l1 = 0.f, m2 = -1e30f, l2 = 0.f;
    for (int t = t0; t < t1; ++t) {
        const int s = (t - t0) & 1;
        if (t + 1 < t1) { DIFF_STORET(s ^ 1); if (t + 2 < t1) DIFF_LOADT(t + 2); }
        const LAS unsigned char* Kb = lds + s * DSTAGE; const LAS unsigned char* Vb = Kb + DK_BYTES;
#pragma unroll
        for (int sub = 0; sub < 2; ++sub) {
            const LAS unsigned char* ka = Kb + (sub * 32 + r32) * KSTR + hh * 16;
            const LAS unsigned char* va = Vb + (sub * 32 + 4 * hh + ((lane & 15) >> 2)) * VSTR + (16 * ((lane >> 4) & 1) + 4 * (lane & 3)) * 2;
            f32x16 s1 = f32x16{}, s2 = f32x16{};
#pragma unroll
            for (int kh = 0; kh < 2; ++kh) {
                const bf16x8 k1a = *(const LAS bf16x8*)(ka + kh * 64), k1b = *(const LAS bf16x8*)(ka + kh * 64 + 32), k2a = *(const LAS bf16x8*)(ka + 128 + kh * 64), k2b = *(const LAS bf16x8*)(ka + 128 + kh * 64 + 32);
                const bf16x8 q1a = *(const LAS bf16x8*)(qa + kh * 64), q1b = *(const LAS bf16x8*)(qa + kh * 64 + 32), q2a = *(const LAS bf16x8*)(qa + 128 + kh * 64), q2b = *(const LAS bf16x8*)(qa + 128 + kh * 64 + 32);
                __builtin_amdgcn_s_setprio(1); s1 = mfma32(k1a, q1a, s1); s2 = mfma32(k2a, q2a, s2); s1 = mfma32(k1b, q1b, s1); s2 = mfma32(k2b, q2b, s2); __builtin_amdgcn_s_setprio(0);
            }
#define DIFF_VFRAG(dt, k2) ({ const s16x4 lo_ = tr_read(va + (16 * (k2)) * VSTR + (dt) * 64), hi_ = tr_read(va + (16 * (k2) + 8) * VSTR + (dt) * 64); \
                (bf16x8){lo_[0], lo_[1], lo_[2], lo_[3], hi_[0], hi_[1], hi_[2], hi_[3]}; })
            bf16x8 vf0 = DIFF_VFRAG(0, 0), vf1 = DIFF_VFRAG(0, 1), vf2 = DIFF_VFRAG(1, 0), vf3 = DIFF_VFRAG(1, 1);
            __builtin_amdgcn_sched_barrier(0);
            bf16x8 p1a, p1b, p2a, p2b;
            sm_step<4>(s1, m1, l1, o1, p1a, p1b);
            sm_step<4>(s2, m2, l2, o2, p2a, p2b);
            __builtin_amdgcn_sched_barrier(0);
            bf16x8 vg0 = DIFF_VFRAG(2, 0), vg1 = DIFF_VFRAG(2, 1), vg2 = DIFF_VFRAG(3, 0), vg3 = DIFF_VFRAG(3, 1);
            __builtin_amdgcn_s_setprio(1);
            o1[0] = mfma32(vf0, p1a, o1[0]); o2[0] = mfma32(vf0, p2a, o2[0]); o1[1] = mfma32(vf2, p1a, o1[1]); o2[1] = mfma32(vf2, p2a, o2[1]);
            o1[0] = mfma32(vf1, p1b, o1[0]); o2[0] = mfma32(vf1, p2b, o2[0]); o1[1] = mfma32(vf3, p1b, o1[1]); o2[1] = mfma32(vf3, p2b, o2[1]);
            __builtin_amdgcn_sched_barrier(0);
            o1[2] = mfma32(vg0, p1a, o1[2]); o2[2] = mfma32(vg0, p2a, o2[2]); o1[3] = mfma32(vg2, p1a, o1[3]); o2[3] = mfma32(vg2, p2a, o2[3]);
            o1[2] = mfma32(vg1, p1b, o1[2]); o2[2] = mfma32(vg1, p2b, o2[2]); o1[3] = mfma32(vg3, p1b, o1[3]); o2[3] = mfma32(vg3, p2b, o2[3]);
            __builtin_amdgcn_s_setprio(0);
#undef DIFF_VFRAG
        }
        __syncthreads();
    }
#undef DIFF_LOADT
#undef DIFF_STORET
    l1 += __shfl_xor(l1, 32); l2 += __shfl_xor(l2, 32);
    const float i1 = 1.0f / l1, i2 = lam / l2;
    float ss = 0.f;
#pragma unroll
    for (int dt = 0; dt < 4; ++dt)
#pragma unroll
        for (int i = 0; i < 16; ++i) { const float v = o1[dt][i] * i1 - o2[dt][i] * i2; o1[dt][i] = v; ss += v * v; }
    ss += __shfl_xor(ss, 32);
    const float rstd = __builtin_amdgcn_rsqf(ss * (1.f / 128.f) + EPS) * oml;
    bf16_t* op = MIX + (size_t)qrow * DM + 512 + h * 128;
#pragma unroll
    for (int dt = 0; dt < 4; ++dt)
#pragma unroll
        for (int g4 = 0; g4 < 4; ++g4) {
            const int e0 = 32 * dt + 8 * g4 + 4 * hh; const f32x4 gv = *(const f32x4*)(sg + e0);
            u32x2 w; w.x = pk2(o1[dt][4 * g4 + 0] * rstd * gv.x, o1[dt][4 * g4 + 1] * rstd * gv.y); w.y = pk2(o1[dt][4 * g4 + 2] * rstd * gv.z, o1[dt][4 * g4 + 3] * rstd * gv.w);
            *(u32x2*)(op + e0) = w;
        }
}

__device__ __forceinline__ void na_block_unit(LAS unsigned char* lds, const LAS float* rpbs, const bf16_t* __restrict__ P, bf16_t* __restrict__ MIX, int b, int hp, int ctxq, int rpq) {
    using namespace att;
    int tid_l = threadIdx.x; asm volatile("" : "+v"(tid_l));
    const int tid = tid_l, lane = tid & 63, wid = __builtin_amdgcn_readfirstlane(tid >> 6), r32 = lane & 31, hh = lane >> 5;
    const int cbw = wid & 3, hsel = wid >> 2, h = hp * 2 + hsel;
    int qrow, nloc = 0, rs0 = 0, band0 = 0, qr = 0, qc = 0, wc0 = 0, rsq = 0;
    if (!ctxq) {
        const int r0 = 2 * rpq; qr = r0 + (r32 >> 4); qc = cbw * 16 + (r32 & 15); qrow = b * SEQ + qr * 64 + qc;
        band0 = min(max(cbw * 16 - 8, 0), 32); wc0 = min(max(qc - 8, 0), 48); rsq = min(max(qr - 4, 0), 120);
        rs0 = min(max(r0 - 4, 0), 120); const int rs1 = min(max(r0 - 3, 0), 120); nloc = rs1 - rs0 + 8;
    } else qrow = MLAT + b * CTX + rpq * 128 + cbw * 32 + r32;
    bf16x8 qf[4];
#pragma unroll
    for (int ks = 0; ks < 4; ++ks) qf[ks] = *(const bf16x8*)(P + (size_t)qrow * INW + h * 64 + 16 * ks + 8 * hh);
    const int nst = 4 + nloc;
    const int srow = tid >> 4, sch = tid & 15;
    const bf16_t* sbase = P + (size_t)srow * INW + hp * 128 + sch * 8;
    u32x4 kreg[2], vreg[2];
#define NA_LOAD(s) do { const int rb_ = (s) < 4 ? MLAT + b * CTX + 64 * (s) : b * SEQ + (rs0 + (s) - 4) * 64; \
        _Pragma("unroll") for (int i_ = 0; i_ < 2; ++i_) { const bf16_t* src_ = sbase + (size_t)(rb_ + 32 * i_) * INW; kreg[i_] = *(const u32x4*)(src_ + 256); vreg[i_] = *(const u32x4*)(src_ + 512); } } while (0)
#define NA_STORE(st) do { _Pragma("unroll") for (int i_ = 0; i_ < 2; ++i_) { \
        *(LAS u32x4*)(lds + (st) * DSTAGE + (srow + 32 * i_) * KSTR + sch * 16) = kreg[i_]; \
        *(LAS u32x4*)(lds + (st) * DSTAGE + DK_BYTES + (srow + 32 * i_) * VSTR + sch * 16) = vreg[i_]; } } while (0)
    NA_LOAD(0); NA_STORE(0); __syncthreads();
    f32x16 o[2]; o[0] = f32x16{}; o[1] = f32x16{};
    float m = -1e30f, l = 0.f;
    for (int s = 0; s < nst; ++s) {
        const int st = s & 1; const bool more = s + 1 < nst;
        if (more) NA_LOAD(s + 1);
        const LAS unsigned char* Kb = lds + st * DSTAGE; const LAS unsigned char* Vb = Kb + DK_BYTES;
        const bool loc = s >= 4; const int nsub = loc ? 1 : 2, kr = rs0 + s - 4;
        for (int sub = 0; sub < nsub; ++sub) {
            const int koff = loc ? band0 : 32 * sub;
            const LAS unsigned char* ka = Kb + (koff + r32) * KSTR + hsel * 128 + hh * 16;
            f32x16 sc = f32x16{};
#pragma unroll
            for (int ks = 0; ks < 4; ++ks) sc = mfma32(*(const LAS bf16x8*)(ka + ks * 32), qf[ks], sc);
            if (loc) {
                const bool rowok = (kr >= rsq) && (kr < rsq + 8); const int drow = kr - qr + 7;
#pragma unroll
                for (int i = 0; i < 16; ++i) { const int kc = band0 + (i & 3) + 8 * (i >> 2) + 4 * hh; const bool ok = rowok && (kc >= wc0) && (kc < wc0 + 16);
                    const int idx = ok ? (drow * 31 + kc - qc + 15) : 0; const float bias = rpbs[h * 465 + idx]; sc[i] = ok ? sc[i] + bias : -1e30f; }
            }
            bf16x8 pa, pb; sm_step<2>(sc, m, l, o, pa, pb);
            const LAS unsigned char* va = Vb + (koff + 4 * hh + ((lane & 15) >> 2)) * VSTR + hsel * 128 + (16 * ((lane >> 4) & 1) + 4 * (lane & 3)) * 2;
#pragma unroll
            for (int dt = 0; dt < 2; ++dt)
#pragma unroll
                for (int k2 = 0; k2 < 2; ++k2) {
                    const s16x4 lo = tr_read(va + (16 * k2) * VSTR + dt * 64), hi = tr_read(va + (16 * k2 + 8) * VSTR + dt * 64);
                    const bf16x8 vf = {lo[0], lo[1], lo[2], lo[3], hi[0], hi[1], hi[2], hi[3]};
                    o[dt] = mfma32(vf, k2 ? pb : pa, o[dt]);
                }
        }
        if (more) NA_STORE(st ^ 1);
        __syncthreads();
    }
#undef NA_LOAD
#undef NA_STORE
    l += __shfl_xor(l, 32);
    const float inv = 1.0f / l;
    bf16_t* op = MIX + (size_t)qrow * DM + h * 64;
#pragma unroll
    for (int dt = 0; dt < 2; ++dt)
#pragma unroll
        for (int g4 = 0; g4 < 4; ++g4) {
            const int e0 = 32 * dt + 8 * g4 + 4 * hh;
            u32x2 w; w.x = pk2(o[dt][4 * g4 + 0] * inv, o[dt][4 * g4 + 1] * inv); w.y = pk2(o[dt][4 * g4 + 2] * inv, o[dt][4 * g4 + 3] * inv);
            *(u32x2*)(op + e0) = w;
        }
}

__device__ __forceinline__ void pool_unit(LAS unsigned char* wl, const bf16_t* __restrict__ P, bf16_t* __restrict__ MIX, const float* __restrict__ pw, const float* __restrict__ pscale, int uid, int lane) {
    asm volatile("" : "+v"(lane));
    const int g = uid & 3, sb = uid >> 2, halfw = 1 << g, r32 = lane & 31, hh = lane >> 5;
    int rowbase, L, T0;
    if (sb < 256) { rowbase = (sb >> 7) * SEQ; L = SEQ; T0 = (sb & 127) * 64; } else { const int s2 = sb - 256; rowbase = MLAT + (s2 >> 2) * CTX; L = CTX; T0 = (s2 & 3) * 64; }
#pragma unroll
    for (int i = 0; i < 10; ++i) { const int c = lane + 64 * i, row = c >> 3, ch = c & 7, tt = T0 - 8 + row;
        u32x4 v = (u32x4){0u, 0u, 0u, 0u};
        if (tt >= 0 && tt < L) v = *(const u32x4*)(P + (size_t)(rowbase + tt) * INW + 768 + g * 64 + ch * 8);
        *(LAS u32x4*)(wl + 128 + row * 128 + ch * 16) = v; }
    bf16x8 wf[2][4];
#pragma unroll
    for (int dt = 0; dt < 2; ++dt)
#pragma unroll
        for (int ks = 0; ks < 4; ++ks) { const float* wp = pw + (size_t)(g * 64 + 16 * ks + 8 * hh) * 64 + 32 * dt + r32;
            u32x4 w4; w4.x = pk2(wp[0], wp[64]); w4.y = pk2(wp[128], wp[192]); w4.z = pk2(wp[256], wp[320]); w4.w = pk2(wp[384], wp[448]); wf[dt][ks] = __builtin_bit_cast(bf16x8, w4); }
    LDS_WAIT();
    const LAS bf16_t* wl16 = (const LAS bf16_t*)(wl + 128) + lane;
    LAS bf16_t* pl = (LAS bf16_t*)wl;
#pragma unroll 4
    for (int tt = 0; tt < 64; ++tt) {
        const int t = T0 + tt, cnt = min(t + halfw, L) - max(t - halfw, 0);
        float sum = 0.f;
#pragma unroll
        for (int j = 0; j < 16; ++j) { const float v = bf2f(wl16[(tt + j) * 64]); sum += (j >= 8 - halfw && j < 8 + halfw) ? v : 0.f; }
        const float pooled = sum * __builtin_amdgcn_rcpf((float)cnt) - bf2f(wl16[(tt + 8) * 64]);
        pl[tt * 64 + lane] = (bf16_t)f2bf(pooled);
    }
    LDS_WAIT();
    const float scl0 = pscale[g * 64 + r32], scl1 = pscale[g * 64 + 32 + r32];
#pragma unroll
    for (int th = 0; th < 2; ++th) {
        f32x16 acc0 = f32x16{}, acc1 = f32x16{};
#pragma unroll
        for (int ks = 0; ks < 4; ++ks) { const bf16x8 af = *(const LAS bf16x8*)((const LAS unsigned char*)pl + (32 * th + r32) * 128 + (16 * ks + 8 * hh) * 2);
            acc0 = mfma32(af, wf[0][ks], acc0); acc1 = mfma32(af, wf[1][ks], acc1); }
        bf16_t* op = MIX + (size_t)(rowbase + T0 + 32 * th) * DM + 256 + g * 64 + r32;
#pragma unroll
        for (int i = 0; i < 16; ++i) { const int row = (i & 3) + 8 * (i >> 2) + 4 * hh; op[(size_t)row * DM] = (bf16_t)f2bf(acc0[i] * scl0); op[(size_t)row * DM + 32] = (bf16_t)f2bf(acc1[i] * scl1); }
    }
    LDS_WAIT();
}

typedef const __attribute__((address_space(4))) Args* ArgP;
__device__ __forceinline__ ArgP argp() { ArgP p = (ArgP)__builtin_amdgcn_kernarg_segment_ptr(); asm volatile("" : "+s"(p)); return p; }
#define WSP(A_, off) ((A_)->ws + (off))

__global__ void __launch_bounds__(NTHR, 2) mk_fwd(Args a_unused) {
    extern __shared__ __attribute__((aligned(16))) unsigned char lds_raw[];
    cg::grid_group grid = cg::this_grid();
    LAS unsigned char* lds = (LAS unsigned char*)lds_raw;
    const int G = gridDim.x, ngw = G * NWAVES;
    volatile LAS unsigned* bar_st = (volatile LAS unsigned*)(lds + BAR_LDS_OFF);
    if (threadIdx.x < 2) bar_st[threadIdx.x] = 0u;
    __syncthreads();
    const XcdBarrier bar = xcd_barrier_post((unsigned*)WSP(argp(), WS_CTL), bar_st);
#define GRID_BAR() xcd_barrier(bar)

    {
        ArgP A = argp();
        int tid_v = threadIdx.x; asm volatile("" : "+v"(tid_v));
        const int tid = tid_v, lane = tid & 63, wid = __builtin_amdgcn_readfirstlane(tid >> 6), gw = blockIdx.x * NWAVES + wid;
        const float* in_c = A->in[1]; const float* in_cctx = A->in[3]; const float* w_ada = A->in[4]; const float* b_ada = A->in[5];
        float* MODS = (float*)WSP(A, WS_MODS); float* CS = (float*)WSP(A, WS_CS);
        LAS float* sl = (LAS float*)lds; LAS float* red = sl + 3072;
        for (int i = tid; i < 3072; i += NTHR) { const int r = i >> 10, k = i & 1023; const float cv = r < 2 ? in_c[r * 1024 + k] : in_cctx[k]; sl[i] = cv / (1.0f + __expf(-cv)); }
        __syncthreads();
        for (int item = blockIdx.x; item < 288; item += G) {
            const int l = item / 144, n0 = (item % 144) * 64;
            const float* W = w_ada + (size_t)l * 1024 * NMODW + n0 + lane;
            float a0 = 0.f, a1 = 0.f, a2 = 0.f;
#pragma unroll 32
            for (int kk = 0; kk < 128; ++kk) { const int k = wid * 128 + kk; const float wv = W[(size_t)k * NMODW]; a0 = fmaf(sl[k], wv, a0); a1 = fmaf(sl[1024 + k], wv, a1); a2 = fmaf(sl[2048 + k], wv, a2); }
            red[(wid * 3 + 0) * 64 + lane] = a0; red[(wid * 3 + 1) * 64 + lane] = a1; red[(wid * 3 + 2) * 64 + lane] = a2;
            __syncthreads();
            if (tid < 192) { const int r = tid >> 6; float s = 0.f;
#pragma unroll
                for (int w8 = 0; w8 < 8; ++w8) s += red[(w8 * 3 + r) * 64 + lane];
                float val = s + b_ada[l * NMODW + n0 + lane];
                { const int col = n0 + lane, c9 = col >> 10, j = col & 1023, idx = c9 / 3, kind = c9 - 3 * idx;
                  const float* ng = A->in[6] + (size_t)l * 6 * DM;
                  if (kind == 1) val = (1.0f + val) * ng[(2 * idx) * DM + j];
                  else if (kind == 2) val = ((idx == 1) ? 1.0f : 0.5f) * val * ng[(2 * idx + 1) * DM + j]; }
                MODS[(size_t)(l * 3 + r) * NMODW + n0 + lane] = val; }
            __syncthreads();
        }
        for (int i = blockIdx.x * NTHR + tid; i < SEQ * 32; i += G * NTHR) {
            const int t = i >> 5, f = i & 31; const float pos = (float)(f < 16 ? (t >> 6) : (t & 63));
            const float inv = __builtin_amdgcn_exp2f(-(float)(f & 15) * 0.8304820237218406f);
            const float rev = pos * inv * 0.15915494309189535f;
            CS[t * 64 + f] = __builtin_amdgcn_cosf(rev); CS[t * 64 + 32 + f] = __builtin_amdgcn_sinf(rev);
        }
        __syncthreads();
        LAS float* scr = (LAS float*)(lds + wid * 16384);
        const float* ffn_w1 = A->in[7]; const float* ffn_w2 = A->in[8]; const float* w_in = A->in[9]; const float* w_out = A->in[10]; unsigned char* ws = A->ws;
        constexpr int N_ITEMS = 2 * (2 * 16 * 176 + 2 * 44 * 32 + 16 * 80 + 16 * 32);
        float wa[32], wb[32];
        int it = gw;
        if (it < N_ITEMS) {
            P0Item Ia = p0_resolve(it, ffn_w1, ffn_w2, w_in, w_out, ws); p0_load(Ia, wa, lane);
            for (;;) {
                const int it1 = it + ngw; P0Item Ib = Ia;
                if (it1 < N_ITEMS) { Ib = p0_resolve(it1, ffn_w1, ffn_w2, w_in, w_out, ws); p0_load(Ib, wb, lane); }
                p0_store(Ia, wa, scr, lane);
                if (it1 >= N_ITEMS) break;
                const int it2 = it1 + ngw;
                if (it2 < N_ITEMS) { Ia = p0_resolve(it2, ffn_w1, ffn_w2, w_in, w_out, ws); p0_load(Ia, wa, lane); }
                p0_store(Ib, wb, scr, lane);
                if (it2 >= N_ITEMS) break;
                it = it2;
            }
        }
    }
    grid.sync();

    for (int l = 0; l < 2; ++l) {
        for (int sub = 0; sub < 3; ++sub) {
            {
                ArgP A = argp();
                int tid_v = threadIdx.x; asm volatile("" : "+v"(tid_v));
                const int lane = tid_v & 63, gw = blockIdx.x * NWAVES + __builtin_amdgcn_readfirstlane(tid_v >> 6);
                const float* norm_g = A->in[6]; const float* MODS = (const float*)WSP(A, WS_MODS); float* XC = (float*)WSP(A, WS_XC);
                PrepP p{};
                const bool first = (l == 0 && sub == 0), src_in = (l == 0 && sub <= 1);
                p.xlat = src_in ? A->in[0] : A->out; p.xctx = src_in ? A->in[2] : XC; p.olat = A->out; p.octx = XC;
                p.Y = (const bf16_t*)WSP(A, WS_Y); p.has_y = first ? 0 : 1;
                if (!first) {
                    const int pl = (sub == 0) ? l - 1 : l, ps = (sub == 0) ? 2 : sub - 1;
                    p.gate = MODS + (size_t)pl * 3 * NMODW + (3 * ps + 2) * 1024; p.gpost = norm_g + (size_t)pl * 6 * DM + (2 * ps + 1) * DM; p.resw = (ps == 1) ? 1.0f : 0.5f;
                }
                p.has_h = 1; p.shift = MODS + (size_t)l * 3 * NMODW + (3 * sub) * 1024; p.gpre = norm_g + (size_t)l * 6 * DM + (2 * sub) * DM; p.H = (bf16_t*)WSP(A, WS_H);
                prep_phase(p, gw, ngw, lane);
            }
            GRID_BAR();
            if (sub != 1) {
                const int s = sub >> 1;
                const bool with_ctx = !(l == 1 && sub == 2);
                if (with_ctx) {
                    ArgP A = argp(); const unsigned char* wl = WSP(A, WS_W + (size_t)l * W_LAYER);
                    unsigned* cnt = (unsigned*)WSP(A, WS_CTL) + CW_UPCNT + 64 * (l * 2 + s);
                    { pg8::Gemm g{(const bf16_t*)WSP(A, WS_H), (const bf16_t*)(wl + s * W1T_BYTES), MTOT, 2 * DFF, DM}; pg8::OrderUpCtxFirst S{(int)blockIdx.x, cnt};
                      pg8::EpiSwiglu E{(bf16_t*)WSP(A, WS_HID), DFF}; pg8::gemm_phase<pg8::EpiSwiglu, pg8::OrderUpCtxFirst, true, true>(lds, g, S, E); }
                    if (blockIdx.x >= 248) {
                        if (threadIdx.x == 0) { unsigned sp = 0; while (__hip_atomic_load(cnt, __ATOMIC_RELAXED, __HIP_MEMORY_SCOPE_AGENT) < 352u && ++sp < (1u << 22)) __builtin_amdgcn_s_sleep(2); }
                        __syncthreads();
                        __builtin_amdgcn_fence(__ATOMIC_ACQUIRE, "agent"); asm volatile("s_waitcnt vmcnt(0)" ::: "memory");
                        __syncthreads();
                        ArgP A2 = argp(); const unsigned char* wl2 = WSP(A2, WS_W + (size_t)l * W_LAYER);
                        pg8::Gemm g{(const bf16_t*)WSP(A2, WS_HID), (const bf16_t*)(wl2 + OFF_W2T + s * W2T_BYTES), MTOT, DM, DFF}; pg8::OrderCtxTail S{(int)blockIdx.x};
                        pg8::EpiY E{(bf16_t*)WSP(A2, WS_Y), DM}; pg8::gemm_phase<pg8::EpiY, pg8::OrderCtxTail, true, true>(lds, g, S, E);
                    }
                } else {
                    ArgP A = argp(); const unsigned char* wl = WSP(A, WS_W + (size_t)l * W_LAYER);
                    pg8::Gemm g{(const bf16_t*)WSP(A, WS_H), (const bf16_t*)(wl + s * W1T_BYTES), MLAT, 2 * DFF, DM}; pg8::StaticOrder S; S.init(MLAT, 2 * DFF, G, (int)blockIdx.x);
                    pg8::EpiSwiglu E{(bf16_t*)WSP(A, WS_HID), DFF}; pg8::gemm_phase<pg8::EpiSwiglu, pg8::StaticOrder, true, true>(lds, g, S, E);
                }
                GRID_BAR();
                { ArgP A = argp(); const unsigned char* wl = WSP(A, WS_W + (size_t)l * W_LAYER);
                  pg8::Gemm g{(const bf16_t*)WSP(A, WS_HID), (const bf16_t*)(wl + OFF_W2T + s * W2T_BYTES), MLAT, DM, DFF}; pg8::StaticOrder S; S.init(MLAT, DM, G, (int)blockIdx.x);
                  pg8::EpiY E{(bf16_t*)WSP(A, WS_Y), DM}; for (int rep = 0; rep < REP_GEMM; ++rep) pg8::gemm_phase<pg8::EpiY, pg8::StaticOrder, true, true>(lds, g, S, E); }
                GRID_BAR();
            } else {
                { ArgP A = argp(); const unsigned char* wl = WSP(A, WS_W + (size_t)l * W_LAYER);
                  pg8::Gemm g{(const bf16_t*)WSP(A, WS_H), (const bf16_t*)(wl + OFF_WIN), MTOT, INW, DM}; pg8::StaticOrder S; S.init(MTOT, INW, G, (int)blockIdx.x);
                  pg8::EpiProj E{(bf16_t*)WSP(A, WS_HID), INW, (const float*)WSP(A, WS_CS), 0.125f * LOG2E}; for (int rep = 0; rep < REP_GEMM; ++rep) pg8::gemm_phase<pg8::EpiProj, pg8::StaticOrder, true, true>(lds, g, S, E); }
                GRID_BAR();
                {
                    ArgP A = argp();
                    int tid_v = threadIdx.x; asm volatile("" : "+v"(tid_v));
                    const int tid = tid_v, lane = tid & 63, wid = __builtin_amdgcn_readfirstlane(tid >> 6);
                    const bf16_t* PJ = (const bf16_t*)WSP(A, WS_HID); bf16_t* MIX = (bf16_t*)WSP(A, WS_H);
                    const float lam_init = __builtin_bit_cast(float, __builtin_amdgcn_readfirstlane(__builtin_bit_cast(int, (l == 0) ? 0.2f : 0.35550906759096926f)));
                    const float* dl = A->in[14] + l * 256; float d01 = 0.f, d23 = 0.f;
                    for (int i = 0; i < 64; ++i) { d01 = fmaf(dl[i], dl[64 + i], d01); d23 = fmaf(dl[128 + i], dl[192 + i], d23); }
                    const float lam = __expf(d01) - __expf(d23) + lam_init;
                    LAS float* rpbs = (LAS float*)(lds + att::RPB_OFF);
                    for (int rep = 0; rep < REP_MIX; ++rep) {
                    const int nun = (l == 0) ? 264 : 256;
                    for (int rd = 0; rd < REP_DIFF; ++rd)
                    for (int u = blockIdx.x; u < nun; u += G) {
                        if (u < 256) diff_unit(lds, PJ, MIX, (u & 7) >> 2, u & 3, 0, u >> 3, lam, 1.0f - lam_init, A->in[15] + l * 128);
                        else diff_unit(lds, PJ, MIX, ((u - 256) & 7) >> 2, (u - 256) & 3, 1, 0, lam, 1.0f - lam_init, A->in[15] + l * 128);
                    }
                    { int tid2 = threadIdx.x; asm volatile("" : "+v"(tid2)); const float* na_rpb = argp()->in[11]; for (int i = tid2; i < 4 * 465; i += NTHR) rpbs[i] = na_rpb[l * 4 * 465 + i] * LOG2E; }
                    __syncthreads();
                    for (int u = blockIdx.x; u < nun; u += G) {
                        if (u < 256) na_block_unit(lds, rpbs, PJ, MIX, (u >> 1) & 1, u & 1, 0, u >> 2);
                        else na_block_unit(lds, rpbs, PJ, MIX, ((u - 256) >> 1) & 1, (u - 256) & 1, 1, (u - 256) >> 2);
                    }
                    { int tid3 = threadIdx.x; asm volatile("" : "+v"(tid3)); const int lane3 = tid3 & 63, wid3 = __builtin_amdgcn_readfirstlane(tid3 >> 6);
                      for (int u = wid3 * G + (int)blockIdx.x; u < nun * 4; u += ngw)
                        pool_unit(lds + wid3 * att::POOL_WAVE_BYTES, PJ, MIX, argp()->in[12] + l * 4 * 64 * 64, argp()->in[13] + l * 256, u, lane3); }
                    __syncthreads();
                    }
                }
                GRID_BAR();
                for (int rep = 0; rep < EXTRA_SYNC; ++rep) GRID_BAR();
                { ArgP A = argp(); const unsigned char* wl = WSP(A, WS_W + (size_t)l * W_LAYER);
                  const int mrows = (l == 0) ? MTOT : MLAT;
                  pg8::Gemm g{(const bf16_t*)WSP(A, WS_H), (const bf16_t*)(wl + OFF_WOUT), mrows, DM, DM}; pg8::StaticOrder S; S.init(mrows, DM, G, (int)blockIdx.x);
                  pg8::EpiY E{(bf16_t*)WSP(A, WS_Y), DM}; for (int rep = 0; rep < REP_GEMM; ++rep) pg8::gemm_phase<pg8::EpiY, pg8::StaticOrder, true, true>(lds, g, S, E); }
                GRID_BAR();
            }
        }
    }
    {
        ArgP A = argp();
        int tid_v = threadIdx.x; asm volatile("" : "+v"(tid_v));
        const int lane = tid_v & 63, gw = blockIdx.x * NWAVES + __builtin_amdgcn_readfirstlane(tid_v >> 6);
        const float* MODS = (const float*)WSP(A, WS_MODS); float* XC = (float*)WSP(A, WS_XC);
        PrepP p{};
        p.xlat = A->out; p.xctx = XC; p.olat = A->out; p.octx = XC; p.Y = (const bf16_t*)WSP(A, WS_Y); p.has_y = 1;
        p.gate = MODS + (size_t)1 * 3 * NMODW + 8 * 1024; p.gpost = A->in[6] + (size_t)1 * 6 * DM + 5 * DM; p.resw = 0.5f; p.has_h = 0;
        prep_phase(p, gw, ngw, lane);
    }
}

extern "C" void kernel_launch(void* const* d_in, const int* in_sizes, int n_in, void* d_out, int out_size, void* d_ws, size_t ws_size, hipStream_t stream) {
    static int grid = 0;
    if (grid == 0) {
        if (n_in != 16 || out_size != MLAT * DM || ws_size < WS_END) { fprintf(stderr, "kernel_launch: unexpected shapes (n_in %d, out %d, ws %zu)\n", n_in, out_size, ws_size); grid = -1; return; }
        int dev = 0, cus = 0, per_cu = 0;
        if (hipGetDevice(&dev) != hipSuccess || hipDeviceGetAttribute(&cus, hipDeviceAttributeMultiprocessorCount, dev) != hipSuccess) { grid = -1; return; }
        if (hipFuncSetAttribute((const void*)mk_fwd, hipFuncAttributeMaxDynamicSharedMemorySize, LDS_BYTES) != hipSuccess) { fprintf(stderr, "kernel_launch: hipFuncSetAttribute failed\n"); grid = -1; return; }
        if (hipOccupancyMaxActiveBlocksPerMultiprocessor(&per_cu, (const void*)mk_fwd, NTHR, LDS_BYTES) != hipSuccess || per_cu < 1) { fprintf(stderr, "kernel_launch: occupancy query reports %d\n", per_cu); (void)hipGetLastError(); grid = -1; return; }
        grid = cus * per_cu;
        if (grid != 256) { fprintf(stderr, "kernel_launch: this build's unit orders need a 256-workgroup grid (got %d x %d)\n", cus, per_cu); grid = -1; return; }
    }
    if (grid < 0) return;
    if (hipMemsetAsync((char*)d_ws + WS_CTL, 0, CTL_ZERO_BYTES, stream) != hipSuccess) { fprintf(stderr, "kernel_launch: hipMemsetAsync failed\n"); return; }
    Args a{};
    for (int i = 0; i < 16; ++i) a.in[i] = (const float*)d_in[i];
    a.out = (float*)d_out; a.ws = (unsigned char*)d_ws;
    void* args[] = {&a};
    hipError_t e = hipLaunchCooperativeKernel((const void*)mk_fwd, dim3(grid), dim3(NTHR), args, LDS_BYTES, stream);
    if (e != hipSuccess) fprintf(stderr, "kernel_launch: cooperative launch failed: %s (grid %d)\n", hipGetErrorString(e), grid);
}
```

```cpp
#include <hip/hip_runtime.h>
#include <hip/hip_cooperative_groups.h>
#include <cstdio>
#include <cstdint>
namespace pg8 {
#define PG8_LAS __attribute__((address_space(3)))
typedef unsigned short bf16_t;
typedef short bf16x8 __attribute__((ext_vector_type(8)));
typedef float f32x4 __attribute__((ext_vector_type(4)));
typedef unsigned u32x4 __attribute__((ext_vector_type(4)));
constexpr int BM = 256, BK = 64, HALF = 128, HTB = HALF * BK * 2  , STAGE_BYTES = 8 * HTB, NXCD = 8, WGM = 8;

__host__ __device__ __forceinline__ int lds_byte(int r, int c) { const int st = (r >> 4) * 2 + (c >> 5), rr = r & 15, cc = c & 31, ob = rr * 64 + cc * 2; return st * 1024 + (ob ^ (((ob >> 9) & 1) << 5)); }
__host__ __device__ __forceinline__ void stage_rc(int b, int& R, int& C) { const int st = b / 1024, sb = b % 1024, swz = sb ^ (((sb >> 9) & 1) << 5); R = (st >> 1) * 16 + swz / 64; C = (st & 1) * 32 + (swz % 64) / 2; }
__host__ __device__ __forceinline__ int perm32(int rho) { const int n = rho >> 4, i = rho & 15; return 8 * (i >> 2) + 4 * n + (i & 3); }

struct Unit { int pm, pn; };
struct Gemm { const bf16_t* A; const bf16_t* Bt; int M, N, K; };

struct StaticOrder {
    int nM, nN, nwg, G, c;
    __host__ __device__ void init(int M, int N, int G_, int c_) { nM = M / BM; nN = N / BM; nwg = nM * nN; G = G_; c = c_; }
    __host__ __device__ bool next(int i, Unit& u) const {
        const long L = (long)i * G + c; if (L >= nwg) return false;
        int wgid = (int)L; { const int q = nwg / NXCD, r = nwg % NXCD, xcd = wgid % NXCD, off = wgid / NXCD; wgid = (xcd < r ? xcd * (q + 1) : r * (q + 1) + (xcd - r) * q) + off; }
        const int nig = WGM * nN, gid = wgid / nig, fm = gid * WGM, gsz = (nM - fm) < WGM ? (nM - fm) : WGM;
        u.pm = fm + ((wgid % nig) % gsz); u.pn = (wgid % nig) / gsz; return true;
    }
    __device__ __forceinline__ void a_ready(const Unit&) const {}
    __device__ __forceinline__ void done(const Unit&) const {}
};

typedef float f32x2 __attribute__((ext_vector_type(2)));
typedef __bf16 pg8_bf16x2 __attribute__((ext_vector_type(2)));
__device__ __forceinline__ unsigned cvt_pk_bf16(float lo, float hi) { f32x2 v = {lo, hi}; pg8_bf16x2 b = __builtin_convertvector(v, pg8_bf16x2); return __builtin_bit_cast(unsigned, b); }
typedef unsigned u32x2 __attribute__((ext_vector_type(2)));
struct EpiSwiglu {
    static constexpr bool PERM = true, AFTER_DRAIN = false;
    bf16_t* O; int ldc;
    __device__ __forceinline__ void operator()(const f32x4 (&acc)[2][2][4][2], const Unit& u, int wr, int wc, int fr, int fq) const {
        const int row0 = u.pm * BM + wr * 64 + fr, col0 = u.pn * 128 + wc * 32 + 8 * fq;
#pragma unroll
        for (int ai = 0; ai < 2; ++ai)
#pragma unroll
            for (int m = 0; m < 4; ++m) {
                bf16_t* rowp = O + (size_t)(row0 + ai * HALF + m * 16) * ldc + col0;
                float r[8];
#pragma unroll
                for (int n = 0; n < 2; ++n)
#pragma unroll
                    for (int e = 0; e < 4; ++e) {
                        const float a = acc[ai][0][m][n][e], b = acc[ai][1][m][n][e];
                        r[n * 4 + e] = a * b * __builtin_amdgcn_rcpf(1.0f + __builtin_amdgcn_exp2f(-a));
                    }
                u32x4 w; w.x = cvt_pk_bf16(r[0], r[1]); w.y = cvt_pk_bf16(r[2], r[3]); w.z = cvt_pk_bf16(r[4], r[5]); w.w = cvt_pk_bf16(r[6], r[7]);
                *(u32x4*)rowp = w;
            }
    }
};
struct EpiY {
    static constexpr bool PERM = true, AFTER_DRAIN = false;
    bf16_t* O; int ldc;
    __device__ __forceinline__ void operator()(const f32x4 (&acc)[2][2][4][2], const Unit& u, int wr, int wc, int fr, int fq) const {
        const int row0 = u.pm * BM + wr * 64 + fr, col0 = u.pn * BM + wc * 32 + 8 * fq;
#pragma unroll
        for (int ai = 0; ai < 2; ++ai)
#pragma unroll
            for (int m = 0; m < 4; ++m) {
                bf16_t* rowp = O + (size_t)(row0 + ai * HALF + m * 16) * ldc + col0;
#pragma unroll
                for (int bj = 0; bj < 2; ++bj) { const f32x4 v0 = acc[ai][bj][m][0], v1 = acc[ai][bj][m][1];
                    u32x4 w; w.x = cvt_pk_bf16(v0[0], v0[1]); w.y = cvt_pk_bf16(v0[2], v0[3]); w.z = cvt_pk_bf16(v1[0], v1[1]); w.w = cvt_pk_bf16(v1[2], v1[3]);
                    *(u32x4*)(rowp + bj * HALF) = w; }
            }
    }
};
struct EpiProj {
    static constexpr bool PERM = true, AFTER_DRAIN = false;
    bf16_t* O; int ldc; const float* cs; float qscale;
    __device__ __forceinline__ void operator()(const f32x4 (&acc)[2][2][4][2], const Unit& u, int wr, int wc, int fr, int fq) const {
        const int row0 = u.pm * BM + wr * 64 + fr;
        const bool rope = (u.pn >= 4 && u.pn < 8);
        if (!rope) {
            const int col0 = u.pn * BM + wc * 32 + 8 * fq;
#pragma unroll
            for (int ai = 0; ai < 2; ++ai)
#pragma unroll
                for (int m = 0; m < 4; ++m) {
                    bf16_t* rowp = O + (size_t)(row0 + ai * HALF + m * 16) * ldc + col0;
#pragma unroll
                    for (int bj = 0; bj < 2; ++bj) {
                        const f32x4 v0 = acc[ai][bj][m][0], v1 = acc[ai][bj][m][1];
                        u32x4 w; w.x = cvt_pk_bf16(v0[0], v0[1]); w.y = cvt_pk_bf16(v0[2], v0[3]); w.z = cvt_pk_bf16(v1[0], v1[1]); w.w = cvt_pk_bf16(v1[2], v1[3]);
                        *(u32x4*)(rowp + bj * HALF) = w;
                    }
                }
        } else {
            const bool lat = (u.pm < 64);
            const int col0 = u.pn * BM + wc * 64 + 8 * fq;
#pragma unroll
            for (int ai = 0; ai < 2; ++ai)
#pragma unroll
                for (int m = 0; m < 4; ++m) {
                    const int row = row0 + ai * HALF + m * 16;
                    bf16_t* rowp = O + (size_t)row * ldc + col0;
                    f32x4 c0 = (f32x4){1.f, 1.f, 1.f, 1.f}, c1 = c0, s0 = (f32x4){0.f, 0.f, 0.f, 0.f}, s1 = s0;
                    if (lat) { const float* cp = cs + (size_t)(row & 8191) * 64 + 8 * fq; c0 = *(const f32x4*)cp; c1 = *(const f32x4*)(cp + 4); s0 = *(const f32x4*)(cp + 32); s1 = *(const f32x4*)(cp + 36); }
                    const f32x4 a0 = acc[ai][0][m][0], a1 = acc[ai][0][m][1], b0 = acc[ai][1][m][0], b1 = acc[ai][1][m][1];
                    const f32x4 y10 = a0 * c0 - b0 * s0, y11 = a1 * c1 - b1 * s1, y20 = a0 * s0 + b0 * c0, y21 = a1 * s1 + b1 * c1;
                    u32x4 w; w.x = cvt_pk_bf16(y10[0], y10[1]); w.y = cvt_pk_bf16(y10[2], y10[3]); w.z = cvt_pk_bf16(y11[0], y11[1]); w.w = cvt_pk_bf16(y11[2], y11[3]);
                    *(u32x4*)rowp = w;
                    w.x = cvt_pk_bf16(y20[0], y20[1]); w.y = cvt_pk_bf16(y20[2], y20[3]); w.z = cvt_pk_bf16(y21[0], y21[1]); w.w = cvt_pk_bf16(y21[2], y21[3]);
                    *(u32x4*)(rowp + 32) = w;
                }
        }
    }
};
struct OrderUpCtxFirst {
    int c; unsigned* cnt;
    __device__ __forceinline__ bool next(int i, Unit& u) const {
        int L;
        if (c < 248) { L = i * 248 + c; if (L >= 1428) return false; } else { if (i >= 3) return false; L = 1428 + (c - 248) * 3 + i; }
        if (L < 44) { u.pm = 64 + L / 22; u.pn = L % 22; return true; }
        int wgid = L - 44; const int nwg = 64 * 22; { const int q = nwg / NXCD, r = nwg % NXCD, xcd = wgid % NXCD, off = wgid / NXCD; wgid = (xcd < r ? xcd * (q + 1) : r * (q + 1) + (xcd - r) * q) + off; }
        const int nig = WGM * 22; const int gid = wgid / nig, fm = gid * WGM;
        u.pm = fm + ((wgid % nig) % WGM); u.pn = (wgid % nig) / WGM; return true;
    }
    __device__ __forceinline__ void a_ready(const Unit&) const {}
    __device__ __forceinline__ void done(const Unit& u) const {
        if (u.pm >= 64) {
            asm volatile("s_waitcnt vmcnt(0)" ::: "memory");
            __builtin_amdgcn_fence(__ATOMIC_RELEASE, "agent");
            asm volatile("s_waitcnt vmcnt(0)" ::: "memory");
            if ((threadIdx.x & 63) == 0) __hip_atomic_fetch_add(cnt, 1u, __ATOMIC_RELAXED, __HIP_MEMORY_SCOPE_AGENT);
        }
    }
};
struct OrderCtxTail {
    int c;
    __device__ __forceinline__ bool next(int i, Unit& u) const { if (i > 0 || c < 248) return false; const int j = c - 248; u.pm = 64 + (j >> 2); u.pn = j & 3; return true; }
    __device__ __forceinline__ void a_ready(const Unit&) const {}
    __device__ __forceinline__ void done(const Unit&) const {}
};
template <class Epi, class Sched, bool ALIGN_EPI = false, bool SP2 = false>
__device__ __forceinline__ void gemm_phase(PG8_LAS unsigned char* lds, const Gemm g, const Sched& S, const Epi& E) {
    int tid_l = threadIdx.x; asm volatile("" : "+v"(tid_l)); const int tid = tid_l, wid = __builtin_amdgcn_readfirstlane(tid >> 6), lane = tid & 63, wr = wid >> 2, wc = wid & 3, fr = lane & 15, fq = lane >> 4;
    const int K = g.K, nt = K / BK;
    unsigned voffA[2], voffB[2];
#pragma unroll
    for (int i = 0; i < 2; ++i) { int R, C; stage_rc(tid * 16 + i * 8192, R, C); const int Rb = Epi::PERM ? ((R & ~31) + perm32(R & 31)) : R;
        voffA[i] = (unsigned)(R * K + C) * 2u; voffB[i] = (unsigned)(Rb * K + C) * 2u; }
    const size_t kstep = (size_t)(BK * 2);
    const size_t hstep = (size_t)HALF * K * 2;
    const size_t tstep = 2 * hstep;
    const unsigned ldsw = (unsigned)wid * 1024u;
    const int aoff = lds_byte(wr * 64 + fr, fq * 8), boff = lds_byte(wc * 32 + fr, fq * 8);
#define PG8_SA(b, h) (((b) * 2 + (h)) * HTB)
#define PG8_SB(b, h) ((4 + (b) * 2 + (h)) * HTB)
#define PG8_STAGE(bufoff, gbase, voff) do { _Pragma("unroll") for (int _i = 0; _i < 2; ++_i) \
        __builtin_amdgcn_global_load_lds((const unsigned*)((const char*)(gbase) + (voff)[_i]), (PG8_LAS unsigned*)(lds + (bufoff) + ldsw + _i * 8192), 16, 0, 0); } while (0)
#define PG8_LDA(dst, b, h) do { _Pragma("unroll") for (int m = 0; m < 4; ++m) _Pragma("unroll") for (int k = 0; k < 2; ++k) dst[m][k] = *(const PG8_LAS bf16x8*)(lds + PG8_SA(b, h) + aoff + m * 2048 + k * 1024); } while (0)
#define PG8_LDB(dst, b, h) do { _Pragma("unroll") for (int n = 0; n < 2; ++n) _Pragma("unroll") for (int k = 0; k < 2; ++k) dst[n][k] = *(const PG8_LAS bf16x8*)(lds + PG8_SB(b, h) + boff + n * 2048 + k * 1024); } while (0)
#define PG8_MMA(ai, bj, At, Bt) do { __builtin_amdgcn_s_setprio(1); _Pragma("unroll") for (int m = 0; m < 4; ++m) _Pragma("unroll") for (int n = 0; n < 2; ++n) _Pragma("unroll") for (int k = 0; k < 2; ++k) \
        acc[ai][bj][m][n] = __builtin_amdgcn_mfma_f32_16x16x32_bf16(Bt[n][k], At[m][k], acc[ai][bj][m][n], 0, 0, 0); __builtin_amdgcn_s_setprio(0); } while (0)
#define PG8_WAIT_V(n) asm volatile("s_waitcnt vmcnt(" #n ")" ::: "memory")
#define PG8_WAIT_L(n) asm volatile("s_waitcnt lgkmcnt(" #n ")" ::: "memory")
#define PG8_BAR __builtin_amdgcn_s_barrier()
#define PG8_SCHED __builtin_amdgcn_sched_barrier(0)
    Unit cur, nxt; int ui = 0;
    if (!S.next(0, cur)) return;
    f32x4 acc[2][2][4][2];
#pragma unroll
    for (int a = 0; a < 2; ++a)
#pragma unroll
        for (int b = 0; b < 2; ++b)
#pragma unroll
            for (int m = 0; m < 4; ++m)
#pragma unroll
                for (int n = 0; n < 2; ++n) acc[a][b][m][n] = (f32x4){0.f, 0.f, 0.f, 0.f};
    bf16x8 At[4][2], B0[2][2], B1[2][2];
    const char* cA = (const char*)g.A + (size_t)cur.pm * tstep; const char* cB = (const char*)g.Bt + (size_t)cur.pn * tstep;
    S.a_ready(cur);
    if constexpr (SP2) {
        PG8_STAGE(PG8_SB(0, 0), cB, voffB); PG8_STAGE(PG8_SB(0, 1), cB + hstep, voffB); PG8_STAGE(PG8_SA(0, 0), cA, voffA); PG8_STAGE(PG8_SA(0, 1), cA + hstep, voffA);
        if (wr == 1) PG8_BAR;
        PG8_WAIT_V(2); PG8_BAR;
        PG8_STAGE(PG8_SB(1, 0), cB + kstep, voffB); PG8_STAGE(PG8_SA(1, 0), cA + kstep, voffA); PG8_STAGE(PG8_SB(1, 1), cB + hstep + kstep, voffB);
        PG8_WAIT_V(6); PG8_BAR;
    } else {
        PG8_STAGE(PG8_SB(0, 0), cB, voffB); PG8_STAGE(PG8_SA(0, 0), cA, voffA); PG8_STAGE(PG8_SB(0, 1), cB + hstep, voffB); PG8_STAGE(PG8_SA(0, 1), cA + hstep, voffA);
        if (wr == 1) PG8_BAR;
        PG8_WAIT_V(4); PG8_BAR;
        PG8_STAGE(PG8_SB(1, 0), cB + kstep, voffB); PG8_STAGE(PG8_SA(1, 0), cA + kstep, voffA); PG8_STAGE(PG8_SB(1, 1), cB + hstep + kstep, voffB);
        PG8_WAIT_V(6); PG8_BAR;
    }
    for (;;) {
        const bool has_next = S.next(ui + 1, nxt);
        const char* nA = has_next ? (const char*)g.A + (size_t)nxt.pm * tstep : cA; const char* nB = has_next ? (const char*)g.Bt + (size_t)nxt.pn * tstep : cB;
        for (int t = 0; t < nt; t += 2) {
            const bool last = (t == nt - 2);
            const char* a1 = cA + (size_t)(t + 1) * kstep;
            const char* a2 = last ? nA : cA + (size_t)(t + 2) * kstep; const char* b2 = last ? nB : cB + (size_t)(t + 2) * kstep;
            const char* a3 = a2 + kstep; const char* b3 = b2 + kstep;
            if (last && has_next) S.a_ready(nxt);
            if constexpr (SP2) {
            PG8_LDB(B0, 0, 0); PG8_LDB(B1, 0, 1); PG8_SCHED; PG8_LDA(At, 0, 0); PG8_STAGE(PG8_SA(1, 1), a1 + hstep, voffA);
            PG8_WAIT_V(8); PG8_WAIT_L(0); PG8_BAR; PG8_MMA(0, 0, At, B0); PG8_MMA(0, 1, At, B1); PG8_BAR; PG8_SCHED;
            PG8_LDA(At, 0, 1); PG8_STAGE(PG8_SB(0, 0), b2, voffB); PG8_STAGE(PG8_SB(0, 1), b2 + hstep, voffB); PG8_STAGE(PG8_SA(0, 0), a2, voffA);
            PG8_WAIT_V(8); PG8_WAIT_L(0); PG8_BAR; PG8_MMA(1, 0, At, B0); PG8_MMA(1, 1, At, B1); PG8_BAR; PG8_SCHED;
            PG8_LDB(B0, 1, 0); PG8_LDB(B1, 1, 1); PG8_SCHED; PG8_LDA(At, 1, 0); PG8_STAGE(PG8_SA(0, 1), a2 + hstep, voffA);
            PG8_WAIT_V(8); PG8_WAIT_L(0); PG8_BAR; PG8_MMA(0, 0, At, B0); PG8_MMA(0, 1, At, B1); PG8_BAR; PG8_SCHED;
            PG8_LDA(At, 1, 1); PG8_STAGE(PG8_SB(1, 0), b3, voffB); PG8_STAGE(PG8_SB(1, 1), b3 + hstep, voffB); PG8_STAGE(PG8_SA(1, 0), a3, voffA);
            PG8_WAIT_V(8); PG8_WAIT_L(0); PG8_BAR; PG8_MMA(1, 0, At, B0); PG8_MMA(1, 1, At, B1); PG8_BAR; PG8_SCHED;
            } else {
            PG8_LDB(B0, 0, 0); PG8_SCHED; PG8_LDA(At, 0, 0); PG8_STAGE(PG8_SA(1, 1), a1 + hstep, voffA);
            PG8_WAIT_L(8); PG8_BAR; PG8_WAIT_L(0); PG8_MMA(0, 0, At, B0); PG8_BAR; PG8_SCHED;
            PG8_LDB(B1, 0, 1); PG8_STAGE(PG8_SB(0, 0), b2, voffB);
            PG8_BAR; PG8_WAIT_L(0); PG8_MMA(0, 1, At, B1); PG8_BAR;
            PG8_LDA(At, 0, 1); PG8_STAGE(PG8_SA(0, 0), a2, voffA);
            PG8_BAR; PG8_WAIT_L(0); PG8_MMA(1, 0, At, B0); PG8_BAR; PG8_SCHED;
            PG8_STAGE(PG8_SB(0, 1), b2 + hstep, voffB);
            PG8_WAIT_V(6); PG8_BAR; PG8_MMA(1, 1, At, B1); PG8_BAR;
            PG8_LDB(B0, 1, 0); PG8_SCHED; PG8_LDA(At, 1, 0); PG8_STAGE(PG8_SA(0, 1), a2 + hstep, voffA);
            PG8_WAIT_L(8); PG8_BAR; PG8_WAIT_L(0); PG8_MMA(0, 0, At, B0); PG8_BAR; PG8_SCHED;
            PG8_LDB(B1, 1, 1); PG8_STAGE(PG8_SB(1, 0), b3, voffB);
            PG8_BAR; PG8_WAIT_L(0); PG8_MMA(0, 1, At, B1); PG8_BAR;
            PG8_LDA(At, 1, 1); PG8_STAGE(PG8_SA(1, 0), a3, voffA);
            PG8_BAR; PG8_WAIT_L(0); PG8_MMA(1, 0, At, B0); PG8_BAR; PG8_SCHED;
            PG8_STAGE(PG8_SB(1, 1), b3 + hstep, voffB);
            PG8_WAIT_V(6); PG8_BAR; PG8_MMA(1, 1, At, B1); PG8_BAR;
            }
        }
        if constexpr (ALIGN_EPI) { if (wr == 0) PG8_BAR; }
        if constexpr (!Epi::AFTER_DRAIN) { E(acc, cur, wr, wc, fr, fq); S.done(cur); }
        if (!has_next) break;
#pragma unroll
        for (int a = 0; a < 2; ++a)
#pragma unroll
            for (int b = 0; b < 2; ++b)
#pragma unroll
                for (int m = 0; m < 4; ++m)
#pragma unroll
                    for (int n = 0; n < 2; ++n) acc[a][b][m][n] = (f32x4){0.f, 0.f, 0.f, 0.f};
        cur = nxt; cA = nA; cB = nB; ++ui;
        if constexpr (ALIGN_EPI) { if (wr == 1) PG8_BAR; }
    }
    PG8_WAIT_V(0);
    if constexpr (!ALIGN_EPI) { if (wr == 0) PG8_BAR; }
    PG8_BAR;
    if constexpr (Epi::AFTER_DRAIN) { E.fused(acc, cur, wr, wc, fr, fq, lds, wid, lane); S.done(cur); }
#undef PG8_SA
#undef PG8_SB
#undef PG8_STAGE
#undef PG8_LDA
#undef PG8_LDB
#undef PG8_MMA
#undef PG8_WAIT_V
#undef PG8_WAIT_L
#undef PG8_BAR
#undef PG8_SCHED
}
}

namespace cg = cooperative_groups;
#define LAS __attribute__((address_space(3)))
typedef unsigned short bf16_t;
typedef short bf16x8 __attribute__((ext_vector_type(8)));
typedef short s16x4 __attribute__((ext_vector_type(4)));
typedef float f32x4 __attribute__((ext_vector_type(4)));
typedef float f32x16 __attribute__((ext_vector_type(16)));
typedef unsigned u32x4 __attribute__((ext_vector_type(4)));
typedef unsigned u32x2 __attribute__((ext_vector_type(2)));
typedef float f32x2_t __attribute__((ext_vector_type(2)));
typedef __bf16 bf16x2_t __attribute__((ext_vector_type(2)));

constexpr int NB = 2, SEQ = 8192, CTX = 256, DM = 1024, DFF = 2816, INW = 2560, NMODW = 9 * 1024;
constexpr int MLAT = NB * SEQ, MCTX = NB * CTX, MTOT = MLAT + MCTX;
constexpr float EPS = 1e-6f, LOG2E = 1.4426950408889634f;
constexpr int NWAVES = 8, NTHR = 512;
#ifndef REP_MIX
#define REP_MIX 1
#endif
#ifndef REP_DIFF
#define REP_DIFF 1
#endif
#ifndef REP_P0
#define REP_P0 1
#endif
#ifndef REP_GEMM
#define REP_GEMM 1
#endif
#ifndef EXTRA_SYNC
#define EXTRA_SYNC 0
#endif
constexpr int LDS_BYTES = 155648;
constexpr size_t MiB = 1u << 20;
constexpr size_t WS_CTL = 0, CTL_ZERO_BYTES = 16384;
constexpr int BAR_LDS_OFF = 151552;
constexpr int CW_UPCNT = 3584;
constexpr size_t WS_MODS = 1 * MiB;
constexpr size_t WS_CS = 2 * MiB;
constexpr size_t WS_XC = 4 * MiB;
constexpr size_t WS_W = 8 * MiB, W_LAYER = 40 * MiB;
constexpr size_t W1T_BYTES = (size_t)2 * DFF * DM * 2, W2T_BYTES = (size_t)DM * DFF * 2, WIN_BYTES = (size_t)INW * DM * 2, WOUT_BYTES = (size_t)DM * DM * 2;
constexpr size_t OFF_W2T = 2 * W1T_BYTES, OFF_WIN = OFF_W2T + 2 * W2T_BYTES, OFF_WOUT = OFF_WIN + WIN_BYTES;
static_assert(OFF_WOUT + WOUT_BYTES == W_LAYER, "weight map");
constexpr size_t WS_H = 88 * MiB;
constexpr size_t WS_Y = 121 * MiB;
constexpr size_t WS_HID = 187 * MiB;
constexpr size_t WS_END = 278 * MiB;

__device__ __forceinline__ unsigned f2bf(float f) { unsigned u = __builtin_bit_cast(unsigned, f); return (u + 0x7fffu + ((u >> 16) & 1u)) >> 16; }
__device__ __forceinline__ unsigned pk2(float lo, float hi) { f32x2_t v = {lo, hi}; bf16x2_t b = __builtin_convertvector(v, bf16x2_t); return __builtin_bit_cast(unsigned, b); }
__device__ __forceinline__ float bf2f(bf16_t v) { return __builtin_bit_cast(float, (unsigned)v << 16); }
__device__ __forceinline__ float wave_sum(float v) {
#pragma unroll
    for (int o = 1; o < 64; o <<= 1) v += __shfl_xor(v, o);
    return v;
}
#define LDS_WAIT() asm volatile("s_waitcnt lgkmcnt(0)" ::: "memory")

struct Args { const float* in[16]; float* out; unsigned char* ws; };

#define XB_TMO      128
#define XB_XCNT(j)  (256  + 64 * (j))
#define XB_XSUB(j)  (1280 + 64 * (j))
#define XB_XGEN(j)  (2304 + 64 * (j))
#define XB_TOP      3328
#define XB_TOPGEN   3392
#define XCD_BAR_WORDS 3456
#define XB_SPIN_CAP (1u << 18)

__device__ __forceinline__ unsigned xb_ld(unsigned* p)              { return __hip_atomic_load(p, __ATOMIC_RELAXED, __HIP_MEMORY_SCOPE_AGENT); }
__device__ __forceinline__ unsigned xb_add(unsigned* p, unsigned v) { return __hip_atomic_fetch_add(p, v, __ATOMIC_RELAXED, __HIP_MEMORY_SCOPE_AGENT); }
__device__ __forceinline__ unsigned xb_xcc_id() { return (unsigned)__builtin_amdgcn_s_getreg((3 << 11) | 20) & 0xFu; }
#define XB_SPIN(cond, bar) do { unsigned _sp = 0; while (cond) { __builtin_amdgcn_s_sleep(1); \
    if ((++_sp & 255u) == 0u) { if (xb_ld(&(bar)[XB_TMO])) break; if (_sp > XB_SPIN_CAP) { atomicAdd(&(bar)[XB_TMO], 1u); break; } } } } while (0)

struct XcdBarrier {
    unsigned* bar; unsigned x;
    volatile LAS unsigned* st;
};

__device__ __forceinline__ XcdBarrier xcd_barrier_post(unsigned* bar, volatile LAS unsigned* st) {
    XcdBarrier b; b.bar = bar; b.x = xb_xcc_id(); b.st = st;
    if (threadIdx.x == 0) (void)xb_add(&bar[XB_XCNT(b.x)], 1u);
    return b;
}
__device__ __forceinline__ void xcd_barrier_complete(unsigned* bar, unsigned x, unsigned& nloc, unsigned& nx) {
    const unsigned G = gridDim.x * gridDim.y * gridDim.z;
    unsigned sum, cnt, mine, sp = 0u;
    for (;;) {
        sum = 0u; cnt = 0u; mine = 0u;
#pragma unroll
        for (unsigned j = 0; j < 16; ++j) { const unsigned c = xb_ld(&bar[XB_XCNT(j)]); sum += c; cnt += (c > 0u) ? 1u : 0u; mine = (j == x) ? c : mine; }
        if (sum == G) break;
        __builtin_amdgcn_s_sleep(1);
        if ((++sp & 255u) == 0u) { if (xb_ld(&bar[XB_TMO])) break; if (sp > XB_SPIN_CAP) { atomicAdd(&bar[XB_TMO], 1u); break; } }
    }
    nloc = mine > 0u ? mine : 1u; nx = cnt > 0u ? cnt : 1u;
}

__device__ __forceinline__ void xcd_barrier(const XcdBarrier& b) {
    asm volatile("s_waitcnt vmcnt(0)" ::: "memory");
    __syncthreads();
    if (threadIdx.x == 0) {
        unsigned* bar = b.bar;
        __builtin_amdgcn_s_waitcnt(0);
        unsigned nloc = b.st[0], nx = b.st[1];
        if (nloc == 0u) { xcd_barrier_complete(bar, b.x, nloc, nx); b.st[0] = nloc; b.st[1] = nx; }
        const unsigned old = xb_add(&bar[XB_XSUB(b.x)], 1u);
        const unsigned gen = old / nloc;
        if (old + 1u == (gen + 1u) * nloc) {
            __builtin_amdgcn_fence(__ATOMIC_RELEASE, "agent");
            asm volatile("s_waitcnt vmcnt(0)" ::: "memory");
            const unsigned og = xb_add(&bar[XB_TOP], 1u);
            const unsigned tg = og / nx;
            if (og + 1u == (tg + 1u) * nx) xb_add(&bar[XB_TOPGEN], 1u);
            else XB_SPIN(xb_ld(&bar[XB_TOPGEN]) == tg, bar);
            __builtin_amdgcn_fence(__ATOMIC_ACQUIRE, "agent");
            xb_add(&bar[XB_XGEN(b.x)], 1u);
            asm volatile("s_waitcnt vmcnt(0)" ::: "memory");
        } else {
            XB_SPIN(xb_ld(&bar[XB_XGEN(b.x)]) == gen, bar);
            __builtin_amdgcn_fence(__ATOMIC_ACQUIRE, "agent");
            asm volatile("s_waitcnt vmcnt(0)" ::: "memory");
        }
    }
    __syncthreads();
}

struct P0Item { const float* src; bf16_t* dst; int N, K; float scale; };
__device__ __forceinline__ P0Item p0_resolve(int it, const float* ffn_w1, const float* ffn_w2, const float* w_in, const float* w_out, unsigned char* ws) {
    constexpr int I_W1 = 16 * 176, I_W2 = 44 * 32, I_IN = 16 * 80, I_OUT = 16 * 32, I_LAYER = 2 * I_W1 + 2 * I_W2 + I_IN + I_OUT;
    const int l = it / I_LAYER; int r = it % I_LAYER; unsigned char* wl = ws + WS_W + (size_t)l * W_LAYER;
    const float* W; bf16_t* WT; int K, N, kind, item;
    if (r < 2 * I_W1) { const int s = r / I_W1; W = ffn_w1 + (size_t)(l * 2 + s) * DM * 2 * DFF; K = DM; N = 2 * DFF; WT = (bf16_t*)(wl + s * W1T_BYTES); kind = 1; item = r % I_W1; }
    else if (r < 2 * I_W1 + 2 * I_W2) { r -= 2 * I_W1; const int s = r / I_W2; W = ffn_w2 + (size_t)(l * 2 + s) * DFF * DM; K = DFF; N = DM; WT = (bf16_t*)(wl + OFF_W2T + s * W2T_BYTES); kind = 0; item = r % I_W2; }
    else if (r < 2 * I_W1 + 2 * I_W2 + I_IN) { r -= 2 * I_W1 + 2 * I_W2; W = w_in + (size_t)l * DM * INW; K = DM; N = INW; WT = (bf16_t*)(wl + OFF_WIN); kind = 2; item = r; }
    else { r -= 2 * I_W1 + 2 * I_W2 + I_IN; W = w_out + (size_t)l * DM * DM; K = DM; N = DM; WT = (bf16_t*)(wl + OFF_WOUT); kind = 0; item = r; }
    const int nblk = N / 32, kb = item / nblk, nb = item % nblk, k0 = 64 * kb, n0 = 32 * nb;
    int d0 = n0; float scale = 1.0f;
    if (kind == 1) { const int half = n0 / DFF, j = n0 % DFF; d0 = (j / 128) * 256 + half * 128 + (j % 128); scale = half ? (1.0f / LOG2E) : LOG2E; }
    else if (kind == 2) { if (n0 < 256 || (n0 >= 1024 && n0 < 1536)) scale = 0.125f * LOG2E;
        if (n0 >= 1024 && n0 < 2048) { const int tile = n0 / 256, c = n0 % 256, vec = c / 64, half = (c % 64) / 32; d0 = tile * 256 + half * 128 + vec * 32; } }
    P0Item I; I.src = W + (size_t)k0 * N + n0; I.dst = WT + (size_t)d0 * K + k0; I.N = N; I.K = K; I.scale = scale; return I;
}
__device__ __forceinline__ void p0_load(const P0Item& I, float (&wv)[32], int lane) {
#pragma unroll
    for (int i = 0; i < 32; ++i) wv[i] = I.src[(size_t)(2 * i + (lane >> 5)) * I.N + (lane & 31)];
}
__device__ __forceinline__ void p0_store(const P0Item& I, const float (&wv)[32], LAS float* scr, int lane) {
#pragma unroll
    for (int i = 0; i < 32; ++i) scr[(2 * i + (lane >> 5)) * 33 + (lane & 31)] = wv[i] * I.scale;
    LDS_WAIT();
    const int c = lane & 7;
#pragma unroll
    for (int j = 0; j < 4; ++j) { const int n = (lane >> 3) + 8 * j; const LAS float* s = scr + (8 * c) * 33 + n;
        u32x4 o; o.x = pk2(s[0 * 33], s[1 * 33]); o.y = pk2(s[2 * 33], s[3 * 33]); o.z = pk2(s[4 * 33], s[5 * 33]); o.w = pk2(s[6 * 33], s[7 * 33]);
        *(u32x4*)(I.dst + (size_t)n * I.K + 8 * c) = o; }
    LDS_WAIT();
}

struct PrepP {
    const float* xlat; const float* xctx;
    float* olat; float* octx;
    const bf16_t* Y; const float* gate; const float* gpost; float resw; int has_y;
    const float* shift; const float* gpre; int has_h; bf16_t* H;
};
__device__ __forceinline__ void prep_phase(const PrepP p, int gw, int ngw, int lane) {
    asm volatile("" : "+v"(lane));
    constexpr int NR = 2;
    f32x4 mg[4], msh[4], msc[4]; int curb = -1;
    for (int r0 = gw; r0 < MTOT; r0 += NR * ngw) {
        { const int bt = (r0 >= MLAT) ? 2 : (r0 >> 13);
          if (bt != curb) { curb = bt;
#pragma unroll
              for (int j = 0; j < 4; ++j) { if (p.has_y) mg[j] = ((const f32x4*)(p.gate + (size_t)bt * NMODW))[lane + 64 * j];
                  if (p.has_h) { msh[j] = ((const f32x4*)(p.shift + (size_t)bt * NMODW))[lane + 64 * j]; msc[j] = ((const f32x4*)(p.shift + 1024 + (size_t)bt * NMODW))[lane + 64 * j]; } } } }
        int rr[NR]; bool ok[NR];
#pragma unroll
        for (int q = 0; q < NR; ++q) { ok[q] = (r0 + q * ngw) < MTOT; rr[q] = ok[q] ? r0 + q * ngw : r0; }
        f32x4 v[NR][4]; u32x2 yb[NR][4];
#pragma unroll
        for (int q = 0; q < NR; ++q) {
            const int r = rr[q]; const bool isc = r >= MLAT;
            const float* xs = isc ? p.xctx + (size_t)(r - MLAT) * DM : p.xlat + (size_t)r * DM;
#pragma unroll
            for (int j = 0; j < 4; ++j) v[q][j] = ((const f32x4*)xs)[lane + 64 * j];
            if (p.has_y) {
#pragma unroll
                for (int j = 0; j < 4; ++j) yb[q][j] = ((const u32x2*)(p.Y + (size_t)r * DM))[lane + 64 * j];
            }
        }
#pragma unroll
        for (int q = 0; q < NR; ++q) {
            const int r = rr[q]; const bool isc = r >= MLAT; const int b3 = isc ? 2 : (r >> 13);
            if (p.has_y) {
                f32x4 y[4]; float ss = 0.f;
#pragma unroll
                for (int j = 0; j < 4; ++j) { y[j] = (f32x4){__builtin_bit_cast(float, yb[q][j].x << 16), __builtin_bit_cast(float, yb[q][j].x & 0xffff0000u), __builtin_bit_cast(float, yb[q][j].y << 16), __builtin_bit_cast(float, yb[q][j].y & 0xffff0000u)};
                    ss += (y[j].x * y[j].x + y[j].y * y[j].y) + (y[j].z * y[j].z + y[j].w * y[j].w); }
                const float rstd = __builtin_amdgcn_rsqf(wave_sum(ss) * (1.f / DM) + EPS);
#pragma unroll
                for (int j = 0; j < 4; ++j) v[q][j] += mg[j] * (y[j] * rstd);
                if (ok[q]) { float* xd = isc ? p.octx + (size_t)(r - MLAT) * DM : p.olat + (size_t)r * DM;
#pragma unroll
                    for (int j = 0; j < 4; ++j) ((f32x4*)xd)[lane + 64 * j] = v[q][j]; }
            }
            if (p.has_h) {
                float ss = 0.f;
#pragma unroll
                for (int j = 0; j < 4; ++j) ss += (v[q][j].x * v[q][j].x + v[q][j].y * v[q][j].y) + (v[q][j].z * v[q][j].z + v[q][j].w * v[q][j].w);
                const float rstd = __builtin_amdgcn_rsqf(wave_sum(ss) * (1.f / DM) + EPS);
#pragma unroll
                for (int j = 0; j < 4; ++j) {
                    const f32x4 hv = (v[q][j] * rstd) * msc[j] + msh[j];
                    u32x2 w; w.x = pk2(hv.x, hv.y); w.y = pk2(hv.z, hv.w);
                    if (ok[q]) ((u32x2*)(p.H + (size_t)r * DM))[lane + 64 * j] = w;
                }
            }
        }
    }
}

__device__ __forceinline__ f32x16 mfma32(bf16x8 a, bf16x8 b, f32x16 c) { return __builtin_amdgcn_mfma_f32_32x32x16_bf16(a, b, c, 0, 0, 0); }
__device__ __forceinline__ s16x4 tr_read(const LAS unsigned char* p) { return __builtin_bit_cast(s16x4, __builtin_amdgcn_ds_read_tr16_b64_v4i16((LAS s16x4*)p)); }
template <int NDT>
__device__ __forceinline__ void sm_step(f32x16& s, float& m, float& l, f32x16 (&o)[NDT], bf16x8& pa, bf16x8& pb) {
    f32x16 p; float ls = 0.f;
#pragma unroll
    for (int i = 0; i < 16; ++i) { p[i] = __builtin_amdgcn_exp2f(s[i] - m); ls += p[i]; }
    if (__any(!(ls < 1.0e6f))) {
        float tm = fmaxf(s[0], s[1]);
#pragma unroll
        for (int i = 2; i < 16; ++i) tm = fmaxf(tm, s[i]);
        tm = fmaxf(tm, __shfl_xor(tm, 32));
        const float mn = fmaxf(m, tm);
        const float alpha = __builtin_amdgcn_exp2f(m - mn);
        l *= alpha;
#pragma unroll
        for (int d = 0; d < NDT; ++d) o[d] = o[d] * alpha;
        m = mn; ls = 0.f;
#pragma unroll
        for (int i = 0; i < 16; ++i) { p[i] = __builtin_amdgcn_exp2f(s[i] - m); ls += p[i]; }
    }
    l += ls;
    u32x4 w0, w1;
    w0.x = pk2(p[0], p[1]); w0.y = pk2(p[2], p[3]); w0.z = pk2(p[4], p[5]); w0.w = pk2(p[6], p[7]);
    w1.x = pk2(p[8], p[9]); w1.y = pk2(p[10], p[11]); w1.z = pk2(p[12], p[13]); w1.w = pk2(p[14], p[15]);
    pa = __builtin_bit_cast(bf16x8, w0); pb = __builtin_bit_cast(bf16x8, w1);
}

namespace att {
constexpr int KSTR = 272, VSTR = 320;
constexpr int DK_BYTES = 64 * KSTR, DV_BYTES = 64 * VSTR, DSTAGE = DK_BYTES + DV_BYTES;
constexpr int NVSTR = 192, NV_BYTES = 32 * NVSTR;
constexpr int RPB_OFF = 88000; constexpr int POOL_WAVE_BYTES = 81 * 128;
constexpr int QLDS_OFF = 2 * DSTAGE, QSTR = 272, QWAVE = 32 * QSTR;
static_assert(QLDS_OFF + NWAVES * QWAVE <= 151552, "diff LDS map");
static_assert(2 * DSTAGE <= RPB_OFF && NWAVES * POOL_WAVE_BYTES <= RPB_OFF && RPB_OFF + 4 * 465 * 4 <= 151552, "attention LDS map");
}

__device__ __forceinline__ void diff_unit(LAS unsigned char* lds, const bf16_t* __restrict__ P, bf16_t* __restrict__ MIX, int b, int h, int ctxq, int qblk,
                                          float lam, float oml, const float* __restrict__ sg) {
    using namespace att;
    int tid_l = threadIdx.x; asm volatile("" : "+v"(tid_l));
    const int tid = tid_l, lane = tid & 63, wid = __builtin_amdgcn_readfirstlane(tid >> 6), r32 = lane & 31, hh = lane >> 5;
    const int qrow = (ctxq ? MLAT + b * CTX : b * SEQ + qblk * 256) + wid * 32 + r32;
    const bf16_t* qp = P + (size_t)qrow * INW + 1024 + h * 128 + 8 * hh;
    const LAS unsigned char* qa = lds + QLDS_OFF + wid * QWAVE + r32 * QSTR + hh * 16;
#pragma unroll
    for (int ks = 0; ks < 4; ++ks) { *(LAS bf16x8*)((LAS unsigned char*)qa + ks * 32) = *(const bf16x8*)(qp + 16 * ks); *(LAS bf16x8*)((LAS unsigned char*)qa + 128 + ks * 32) = *(const bf16x8*)(qp + 64 + 16 * ks); }
    const int t0 = ctxq ? 128 : 0, t1 = 132;
    const int srow = tid >> 4, sch = tid & 15;
    u32x4 kreg[2], vreg[2];
    const bf16_t* sbase = P + (size_t)srow * INW + h * 128 + sch * 8;
#define DIFF_LOADT(t) do { const int rb_ = ((t) < 128 ? b * SEQ + 64 * (t) : MLAT + b * CTX + 64 * ((t) - 128)); \
        _Pragma("unroll") for (int i_ = 0; i_ < 2; ++i_) { const bf16_t* src_ = sbase + (size_t)(rb_ + 32 * i_) * INW; kreg[i_] = *(const u32x4*)(src_ + 1536); vreg[i_] = *(const u32x4*)(src_ + 2048); } } while (0)
#define DIFF_STORET(s) do { _Pragma("unroll") for (int i_ = 0; i_ < 2; ++i_) { *(LAS u32x4*)(lds + (s) * DSTAGE + (srow + 32 * i_) * KSTR + sch * 16) = kreg[i_]; \
        *(LAS u32x4*)(lds + (s) * DSTAGE + DK_BYTES + (srow + 32 * i_) * VSTR + sch * 16) = vreg[i_]; } } while (0)
    DIFF_LOADT(t0); DIFF_STORET(0); if (t0 + 1 < t1) DIFF_LOADT(t0 + 1); __syncthreads();
    f32x16 o1[4], o2[4];
#pragma unroll
    for (int d = 0; d < 4; ++d) { o1[d] = f32x16{}; o2[d] = f32x16{}; }
    float m1 = -1e30f, l1 = 0.f, m2 = -1e30f, l2 = 0.f;
    for (int t = t0; t < t1; ++t) {
        const int s = (t - t0) & 1;
        if (t + 1 < t1) { DIFF_STORET(s ^ 1); if (t + 2 < t1) DIFF_LOADT(t + 2); }
        const LAS unsigned char* Kb = lds + s * DSTAGE; const LAS unsigned char* Vb = Kb + DK_BYTES;
#pragma unroll
        for (int sub = 0; sub < 2; ++sub) {
            const LAS unsigned char* ka = Kb + (sub * 32 + r32) * KSTR + hh * 16;
            const LAS unsigned char* va = Vb + (sub * 32 + 4 * hh + ((lane & 15) >> 2)) * VSTR + (16 * ((lane >> 4) & 1) + 4 * (lane & 3)) * 2;
            f32x16 s1 = f32x16{}, s2 = f32x16{};
#pragma unroll
            for (int kh = 0; kh < 2; ++kh) {
                const bf16x8 k1a = *(const LAS bf16x8*)(ka + kh * 64), k1b = *(const LAS bf16x8*)(ka + kh * 64 + 32), k2a = *(const LAS bf16x8*)(ka + 128 + kh * 64), k2b = *(const LAS bf16x8*)(ka + 128 + kh * 64 + 32);
                const bf16x8 q1a = *(const LAS bf16x8*)(qa + kh * 64), q1b = *(const LAS bf16x8*)(qa + kh * 64 + 32), q2a = *(const LAS bf16x8*)(qa + 128 + kh * 64), q2b = *(const LAS bf16x8*)(qa + 128 + kh * 64 + 32);
                __builtin_amdgcn_s_setprio(1); s1 = mfma32(k1a, q1a, s1); s2 = mfma32(k2a, q2a, s2); s1 = mfma32(k1b, q1b, s1); s2 = mfma32(k2b, q2b, s2); __builtin_amdgcn_s_setprio(0);
            }
#define DIFF_VFRAG(dt, k2) ({ const s16x4 lo_ = tr_read(va + (16 * (k2)) * VSTR + (dt) * 64), hi_ = tr_read(va + (16 * (k2) + 8) * VSTR + (dt) * 64); \
                (bf16x8){lo_[0], lo_[1], lo_[2], lo_[3], hi_[0], hi_[1], hi_[2], hi_[3]}; })
            bf16x8 vf0 = DIFF_VFRAG(0, 0), vf1 = DIFF_VFRAG(0, 1), vf2 = DIFF_VFRAG(1, 0), vf3 = DIFF_VFRAG(1, 1);
            __builtin_amdgcn_sched_barrier(0);
            bf16x8 p1a, p1b, p2a, p2b;
            sm_step<4>(s1, m1, l1, o1, p1a, p1b);
            sm_step<4>(s2, m2, l2, o2, p2a, p2b);
            __builtin_amdgcn_sched_barrier(0);
            bf16x8 vg0 = DIFF_VFRAG(2, 0), vg1 = DIFF_VFRAG(2, 1), vg2 = DIFF_VFRAG(3, 0), vg3 = DIFF_VFRAG(3, 1);
            __builtin_amdgcn_s_setprio(1);
            o1[0] = mfma32(vf0, p1a, o1[0]); o2[0] = mfma32(vf0, p2a, o2[0]); o1[1] = mfma32(vf2, p1a, o1[1]); o2[1] = mfma32(vf2, p2a, o2[1]);
            o1[0] = mfma32(vf1, p1b, o1[0]); o2[0] = mfma32(vf1, p2b, o2[0]); o1[1] = mfma32(vf3, p1b, o1[1]); o2[1] = mfma32(vf3, p2b, o2[1]);
            __builtin_amdgcn_sched_barrier(0);
            o1[2] = mfma32(vg0, p1a, o1[2]); o2[2] = mfma32(vg0, p2a, o2[2]); o1[3] = mfma32(vg2, p1a, o1[3]); o2[3] = mfma32(vg2, p2a, o2[3]);
            o1[2] = mfma32(vg1, p1b, o1[2]); o2[2] = mfma32(vg1, p2b, o2[2]); o1[3] = mfma32(vg3, p1b, o1[3]); o2[3] = mfma32(vg3, p2b, o2[3]);
            __builtin_amdgcn_s_setprio(0);
#undef DIFF_VFRAG
        }
        __syncthreads();
    }
#undef DIFF_LOADT
#undef DIFF_STORET
    l1 += __shfl_xor(l1, 32); l2 += __shfl_xor(l2, 32);
    const float i1 = 1.0f / l1, i2 = lam / l2;
    float ss = 0.f;
#pragma unroll
    for (int dt = 0; dt < 4; ++dt)
#pragma unroll
        for (int i = 0; i < 16; ++i) { const float v = o1[dt][i] * i1 - o2[dt][i] * i2; o1[dt][i] = v; ss += v * v; }
    ss += __shfl_xor(ss, 32);
    const float rstd = __builtin_amdgcn_rsqf(ss * (1.f / 128.f) + EPS) * oml;
    bf16_t* op = MIX + (size_t)qrow * DM + 512 + h * 128;
#pragma unroll
    for (int dt = 0; dt < 4; ++dt)
#pragma unroll
        for (int g4 = 0; g4 < 4; ++g4) {
            const int e0 = 32 * dt + 8 * g4 + 4 * hh; const f32x4 gv = *(const f32x4*)(sg + e0);
            u32x2 w; w.x = pk2(o1[dt][4 * g4 + 0] * rstd * gv.x, o1[dt][4 * g4 + 1] * rstd * gv.y); w.y = pk2(o1[dt][4 * g4 + 2] * rstd * gv.z, o1[dt][4 * g4 + 3] * rstd * gv.w);
            *(u32x2*)(op + e0) = w;
        }
}

__device__ __forceinline__ void na_block_unit(LAS unsigned char* lds, const LAS float* rpbs, const bf16_t* __restrict__ P, bf16_t* __restrict__ MIX, int b, int hp, int ctxq, int rpq) {
    using namespace att;
    int tid_l = threadIdx.x; asm volatile("" : "+v"(tid_l));
    const int tid = tid_l, lane = tid & 63, wid = __builtin_amdgcn_readfirstlane(tid >> 6), r32 = lane & 31, hh = lane >> 5;
    const int cbw = wid & 3, hsel = wid >> 2, h = hp * 2 + hsel;
    int qrow, nloc = 0, rs0 = 0, band0 = 0, qr = 0, qc = 0, wc0 = 0, rsq = 0;
    if (!ctxq) {
        const int r0 = 2 * rpq; qr = r0 + (r32 >> 4); qc = cbw * 16 + (r32 & 15); qrow = b * SEQ + qr * 64 + qc;
        band0 = min(max(cbw * 16 - 8, 0), 32); wc0 = min(max(qc - 8, 0), 48); rsq = min(max(qr - 4, 0), 120);
        rs0 = min(max(r0 - 4, 0), 120); const int rs1 = min(max(r0 - 3, 0), 120); nloc = rs1 - rs0 + 8;
    } else qrow = MLAT + b * CTX + rpq * 128 + cbw * 32 + r32;
    bf16x8 qf[4];
#pragma unroll
    for (int ks = 0; ks < 4; ++ks) qf[ks] = *(const bf16x8*)(P + (size_t)qrow * INW + h * 64 + 16 * ks + 8 * hh);
    const int nst = 4 + nloc;
    const int srow = tid >> 4, sch = tid & 15;
    const bf16_t* sbase = P + (size_t)srow * INW + hp * 128 + sch * 8;
    u32x4 kreg[2], vreg[2];
#define NA_LOAD(s) do { const int rb_ = (s) < 4 ? MLAT + b * CTX + 64 * (s) : b * SEQ + (rs0 + (s) - 4) * 64; \
        _Pragma("unroll") for (int i_ = 0; i_ < 2; ++i_) { const bf16_t* src_ = sbase + (size_t)(rb_ + 32 * i_) * INW; kreg[i_] = *(const u32x4*)(src_ + 256); vreg[i_] = *(const u32x4*)(src_ + 512); } } while (0)
#define NA_STORE(st) do { _Pragma("unroll") for (int i_ = 0; i_ < 2; ++i_) { \
        *(LAS u32x4*)(lds + (st) * DSTAGE + (srow + 32 * i_) * KSTR + sch * 16) = kreg[i_]; \
        *(LAS u32x4*)(lds + (st) * DSTAGE + DK_BYTES + (srow + 32 * i_) * VSTR + sch * 16) = vreg[i_]; } } while (0)
    NA_LOAD(0); NA_STORE(0); __syncthreads();
    f32x16 o[2]; o[0] = f32x16{}; o[1] = f32x16{};
    float m = -1e30f, l = 0.f;
    for (int s = 0; s < nst; ++s) {
        const int st = s & 1; const bool more = s + 1 < nst;
        if (more) NA_LOAD(s + 1);
        const LAS unsigned char* Kb = lds + st * DSTAGE; const LAS unsigned char* Vb = Kb + DK_BYTES;
        const bool loc = s >= 4; const int nsub = loc ? 1 : 2, kr = rs0 + s - 4;
        for (int sub = 0; sub < nsub; ++sub) {
            const int koff = loc ? band0 : 32 * sub;
            const LAS unsigned char* ka = Kb + (koff + r32) * KSTR + hsel * 128 + hh * 16;
            f32x16 sc = f32x16{};
#pragma unroll
            for (int ks = 0; ks < 4; ++ks) sc = mfma32(*(const LAS bf16x8*)(ka + ks * 32), qf[ks], sc);
            if (loc) {
                const bool rowok = (kr >= rsq) && (kr < rsq + 8); const int drow = kr - qr + 7;
#pragma unroll
                for (int i = 0; i < 16; ++i) { const int kc = band0 + (i & 3) + 8 * (i >> 2) + 4 * hh; const bool ok = rowok && (kc >= wc0) && (kc < wc0 + 16);
                    const int idx = ok ? (drow * 31 + kc - qc + 15) : 0; const float bias = rpbs[h * 465 + idx]; sc[i] = ok ? sc[i] + bias : -1e30f; }
            }
            bf16x8 pa, pb; sm_step<2>(sc, m, l, o, pa, pb);
            const LAS unsigned char* va = Vb + (koff + 4 * hh + ((lane & 15) >> 2)) * VSTR + hsel * 128 + (16 * ((lane >> 4) & 1) + 4 * (lane & 3)) * 2;
#pragma unroll
            for (int dt = 0; dt < 2; ++dt)
#pragma unroll
                for (int k2 = 0; k2 < 2; ++k2) {
                    const s16x4 lo = tr_read(va + (16 * k2) * VSTR + dt * 64), hi = tr_read(va + (16 * k2 + 8) * VSTR + dt * 64);
                    const bf16x8 vf = {lo[0], lo[1], lo[2], lo[3], hi[0], hi[1], hi[2], hi[3]};
                    o[dt] = mfma32(vf, k2 ? pb : pa, o[dt]);
                }
        }
        if (more) NA_STORE(st ^ 1);
        __syncthreads();
    }
#undef NA_LOAD
#undef NA_STORE
    l += __shfl_xor(l, 32);
    const float inv = 1.0f / l;
    bf16_t* op = MIX + (size_t)qrow * DM + h * 64;
#pragma unroll
    for (int dt = 0; dt < 2; ++dt)
#pragma unroll
        for (int g4 = 0; g4 < 4; ++g4) {
            const int e0 = 32 * dt + 8 * g4 + 4 * hh;
            u32x2 w; w.x = pk2(o[dt][4 * g4 + 0] * inv, o[dt][4 * g4 + 1] * inv); w.y = pk2(o[dt][4 * g4 + 2] * inv, o[dt][4 * g4 + 3] * inv);
            *(u32x2*)(op + e0) = w;
        }
}

__device__ __forceinline__ void pool_unit(LAS unsigned char* wl, const bf16_t* __restrict__ P, bf16_t* __restrict__ MIX, const float* __restrict__ pw, const float* __restrict__ pscale, int uid, int lane) {
    asm volatile("" : "+v"(lane));
    const int g = uid & 3, sb = uid >> 2, halfw = 1 << g, r32 = lane & 31, hh = lane >> 5;
    int rowbase, L, T0;
    if (sb < 256) { rowbase = (sb >> 7) * SEQ; L = SEQ; T0 = (sb & 127) * 64; } else { const int s2 = sb - 256; rowbase = MLAT + (s2 >> 2) * CTX; L = CTX; T0 = (s2 & 3) * 64; }
#pragma unroll
    for (int i = 0; i < 10; ++i) { const int c = lane + 64 * i, row = c >> 3, ch = c & 7, tt = T0 - 8 + row;
        u32x4 v = (u32x4){0u, 0u, 0u, 0u};
        if (tt >= 0 && tt < L) v = *(const u32x4*)(P + (size_t)(rowbase + tt) * INW + 768 + g * 64 + ch * 8);
        *(LAS u32x4*)(wl + 128 + row * 128 + ch * 16) = v; }
    bf16x8 wf[2][4];
#pragma unroll
    for (int dt = 0; dt < 2; ++dt)
#pragma unroll
        for (int ks = 0; ks < 4; ++ks) { const float* wp = pw + (size_t)(g * 64 + 16 * ks + 8 * hh) * 64 + 32 * dt + r32;
            u32x4 w4; w4.x = pk2(wp[0], wp[64]); w4.y = pk2(wp[128], wp[192]); w4.z = pk2(wp[256], wp[320]); w4.w = pk2(wp[384], wp[448]); wf[dt][ks] = __builtin_bit_cast(bf16x8, w4); }
    LDS_WAIT();
    const LAS bf16_t* wl16 = (const LAS bf16_t*)(wl + 128) + lane;
    LAS bf16_t* pl = (LAS bf16_t*)wl;
#pragma unroll 4
    for (int tt = 0; tt < 64; ++tt) {
        const int t = T0 + tt, cnt = min(t + halfw, L) - max(t - halfw, 0);
        float sum = 0.f;
#pragma unroll
        for (int j = 0; j < 16; ++j) { const float v = bf2f(wl16[(tt + j) * 64]); sum += (j >= 8 - halfw && j < 8 + halfw) ? v : 0.f; }
        const float pooled = sum * __builtin_amdgcn_rcpf((float)cnt) - bf2f(wl16[(tt + 8) * 64]);
        pl[tt * 64 + lane] = (bf16_t)f2bf(pooled);
    }
    LDS_WAIT();
    const float scl0 = pscale[g * 64 + r32], scl1 = pscale[g * 64 + 32 + r32];
#pragma unroll
    for (int th = 0; th < 2; ++th) {
        f32x16 acc0 = f32x16{}, acc1 = f32x16{};
#pragma unroll
        for (int ks = 0; ks < 4; ++ks) { const bf16x8 af = *(const LAS bf16x8*)((const LAS unsigned char*)pl + (32 * th + r32) * 128 + (16 * ks + 8 * hh) * 2);
            acc0 = mfma32(af, wf[0][ks], acc0); acc1 = mfma32(af, wf[1][ks], acc1); }
        bf16_t* op = MIX + (size_t)(rowbase + T0 + 32 * th) * DM + 256 + g * 64 + r32;
#pragma unroll
        for (int i = 0; i < 16; ++i) { const int row = (i & 3) + 8 * (i >> 2) + 4 * hh; op[(size_t)row * DM] = (bf16_t)f2bf(acc0[i] * scl0); op[(size_t)row * DM + 32] = (bf16_t)f2bf(acc1[i] * scl1); }
    }
    LDS_WAIT();
}

typedef const __attribute__((address_space(4))) Args* ArgP;
__device__ __forceinline__ ArgP argp() { ArgP p = (ArgP)__builtin_amdgcn_kernarg_segment_ptr(); asm volatile("" : "+s"(p)); return p; }
#define WSP(A_, off) ((A_)->ws + (off))

__global__ void __launch_bounds__(NTHR, 2) mk_fwd(Args a_unused) {
    extern __shared__ __attribute__((aligned(16))) unsigned char lds_raw[];
    cg::grid_group grid = cg::this_grid();
    LAS unsigned char* lds = (LAS unsigned char*)lds_raw;
    const int G = gridDim.x, ngw = G * NWAVES;
    volatile LAS unsigned* bar_st = (volatile LAS unsigned*)(lds + BAR_LDS_OFF);
    if (threadIdx.x < 2) bar_st[threadIdx.x] = 0u;
    __syncthreads();
    const XcdBarrier bar = xcd_barrier_post((unsigned*)WSP(argp(), WS_CTL), bar_st);
#define GRID_BAR() xcd_barrier(bar)

    {
        ArgP A = argp();
        int tid_v = threadIdx.x; asm volatile("" : "+v"(tid_v));
        const int tid = tid_v, lane = tid & 63, wid = __builtin_amdgcn_readfirstlane(tid >> 6), gw = blockIdx.x * NWAVES + wid;
        const float* in_c = A->in[1]; const float* in_cctx = A->in[3]; const float* w_ada = A->in[4]; const float* b_ada = A->in[5];
        float* MODS = (float*)WSP(A, WS_MODS); float* CS = (float*)WSP(A, WS_CS);
        LAS float* sl = (LAS float*)lds; LAS float* red = sl + 3072;
        for (int i = tid; i < 3072; i += NTHR) { const int r = i >> 10, k = i & 1023; const float cv = r < 2 ? in_c[r * 1024 + k] : in_cctx[k]; sl[i] = cv / (1.0f + __expf(-cv)); }
        __syncthreads();
        for (int item = blockIdx.x; item < 288; item += G) {
            const int l = item / 144, n0 = (item % 144) * 64;
            const float* W = w_ada + (size_t)l * 1024 * NMODW + n0 + lane;
            float a0 = 0.f, a1 = 0.f, a2 = 0.f;
#pragma unroll 32
            for (int kk = 0; kk < 128; ++kk) { const int k = wid * 128 + kk; const float wv = W[(size_t)k * NMODW]; a0 = fmaf(sl[k], wv, a0); a1 = fmaf(sl[1024 + k], wv, a1); a2 = fmaf(sl[2048 + k], wv, a2); }
            red[(wid * 3 + 0) * 64 + lane] = a0; red[(wid * 3 + 1) * 64 + lane] = a1; red[(wid * 3 + 2) * 64 + lane] = a2;
            __syncthreads();
            if (tid < 192) { const int r = tid >> 6; float s = 0.f;
#pragma unroll
                for (int w8 = 0; w8 < 8; ++w8) s += red[(w8 * 3 + r) * 64 + lane];
                float val = s + b_ada[l * NMODW + n0 + lane];
                { const int col = n0 + lane, c9 = col >> 10, j = col & 1023, idx = c9 / 3, kind = c9 - 3 * idx;
                  const float* ng = A->in[6] + (size_t)l * 6 * DM;
                  if (kind == 1) val = (1.0f + val) * ng[(2 * idx) * DM + j];
                  else if (kind == 2) val = ((idx == 1) ? 1.0f : 0.5f) * val * ng[(2 * idx + 1) * DM + j]; }
                MODS[(size_t)(l * 3 + r) * NMODW + n0 + lane] = val; }
            __syncthreads();
        }
        for (int i = blockIdx.x * NTHR + tid; i < SEQ * 32; i += G * NTHR) {
            const int t = i >> 5, f = i & 31; const float pos = (float)(f < 16 ? (t >> 6) : (t & 63));
            const float inv = __builtin_amdgcn_exp2f(-(float)(f & 15) * 0.8304820237218406f);
            const float rev = pos * inv * 0.15915494309189535f;
            CS[t * 64 + f] = __builtin_amdgcn_cosf(rev); CS[t * 64 + 32 + f] = __builtin_amdgcn_sinf(rev);
        }
        __syncthreads();
        LAS float* scr = (LAS float*)(lds + wid * 16384);
        const float* ffn_w1 = A->in[7]; const float* ffn_w2 = A->in[8]; const float* w_in = A->in[9]; const float* w_out = A->in[10]; unsigned char* ws = A->ws;
        constexpr int N_ITEMS = 2 * (2 * 16 * 176 + 2 * 44 * 32 + 16 * 80 + 16 * 32);
        float wa[32], wb[32];
        int it = gw;
        if (it < N_ITEMS) {
            P0Item Ia = p0_resolve(it, ffn_w1, ffn_w2, w_in, w_out, ws); p0_load(Ia, wa, lane);
            for (;;) {
                const int it1 = it + ngw; P0Item Ib = Ia;
                if (it1 < N_ITEMS) { Ib = p0_resolve(it1, ffn_w1, ffn_w2, w_in, w_out, ws); p0_load(Ib, wb, lane); }
                p0_store(Ia, wa, scr, lane);
                if (it1 >= N_ITEMS) break;
                const int it2 = it1 + ngw;
                if (it2 < N_ITEMS) { Ia = p0_resolve(it2, ffn_w1, ffn_w2, w_in, w_out, ws); p0_load(Ia, wa, lane); }
                p0_store(Ib, wb, scr, lane);
                if (it2 >= N_ITEMS) break;
                it = it2;
            }
        }
    }
    grid.sync();

    for (int l = 0; l < 2; ++l) {
        for (int sub = 0; sub < 3; ++sub) {
            {
                ArgP A = argp();
                int tid_v = threadIdx.x; asm volatile("" : "+v"(tid_v));
                const int lane = tid_v & 63, gw = blockIdx.x * NWAVES + __builtin_amdgcn_readfirstlane(tid_v >> 6);
                const float* norm_g = A->in[6]; const float* MODS = (const float*)WSP(A, WS_MODS); float* XC = (float*)WSP(A, WS_XC);
                PrepP p{};
                const bool first = (l == 0 && sub == 0), src_in = (l == 0 && sub <= 1);
                p.xlat = src_in ? A->in[0] : A->out; p.xctx = src_in ? A->in[2] : XC; p.olat = A->out; p.octx = XC;
                p.Y = (const bf16_t*)WSP(A, WS_Y); p.has_y = first ? 0 : 1;
                if (!first) {
                    const int pl = (sub == 0) ? l - 1 : l, ps = (sub == 0) ? 2 : sub - 1;
                    p.gate = MODS + (size_t)pl * 3 * NMODW + (3 * ps + 2) * 1024; p.gpost = norm_g + (size_t)pl * 6 * DM + (2 * ps + 1) * DM; p.resw = (ps == 1) ? 1.0f : 0.5f;
                }
                p.has_h = 1; p.shift = MODS + (size_t)l * 3 * NMODW + (3 * sub) * 1024; p.gpre = norm_g + (size_t)l * 6 * DM + (2 * sub) * DM; p.H = (bf16_t*)WSP(A, WS_H);
                prep_phase(p, gw, ngw, lane);
            }
            GRID_BAR();
            if (sub != 1) {
                const int s = sub >> 1;
                const bool with_ctx = !(l == 1 && sub == 2);
                if (with_ctx) {
                    ArgP A = argp(); const unsigned char* wl = WSP(A, WS_W + (size_t)l * W_LAYER);
                    unsigned* cnt = (unsigned*)WSP(A, WS_CTL) + CW_UPCNT + 64 * (l * 2 + s);
                    { pg8::Gemm g{(const bf16_t*)WSP(A, WS_H), (const bf16_t*)(wl + s * W1T_BYTES), MTOT, 2 * DFF, DM}; pg8::OrderUpCtxFirst S{(int)blockIdx.x, cnt};
                      pg8::EpiSwiglu E{(bf16_t*)WSP(A, WS_HID), DFF}; pg8::gemm_phase<pg8::EpiSwiglu, pg8::OrderUpCtxFirst, true, true>(lds, g, S, E); }
                    if (blockIdx.x >= 248) {
                        if (threadIdx.x == 0) { unsigned sp = 0; while (__hip_atomic_load(cnt, __ATOMIC_RELAXED, __HIP_MEMORY_SCOPE_AGENT) < 352u && ++sp < (1u << 22)) __builtin_amdgcn_s_sleep(2); }
                        __syncthreads();
                        __builtin_amdgcn_fence(__ATOMIC_ACQUIRE, "agent"); asm volatile("s_waitcnt vmcnt(0)" ::: "memory");
                        __syncthreads();
                        ArgP A2 = argp(); const unsigned char* wl2 = WSP(A2, WS_W + (size_t)l * W_LAYER);
                        pg8::Gemm g{(const bf16_t*)WSP(A2, WS_HID), (const bf16_t*)(wl2 + OFF_W2T + s * W2T_BYTES), MTOT, DM, DFF}; pg8::OrderCtxTail S{(int)blockIdx.x};
                        pg8::EpiY E{(bf16_t*)WSP(A2, WS_Y), DM}; pg8::gemm_phase<pg8::EpiY, pg8::OrderCtxTail, true, true>(lds, g, S, E);
                    }
                } else {
                    ArgP A = argp(); const unsigned char* wl = WSP(A, WS_W + (size_t)l * W_LAYER);
                    pg8::Gemm g{(const bf16_t*)WSP(A, WS_H), (const bf16_t*)(wl + s * W1T_BYTES), MLAT, 2 * DFF, DM}; pg8::StaticOrder S; S.init(MLAT, 2 * DFF, G, (int)blockIdx.x);
                    pg8::EpiSwiglu E{(bf16_t*)WSP(A, WS_HID), DFF}; pg8::gemm_phase<pg8::EpiSwiglu, pg8::StaticOrder, true, true>(lds, g, S, E);
                }
                GRID_BAR();
                { ArgP A = argp(); const unsigned char* wl = WSP(A, WS_W + (size_t)l * W_LAYER);
                  pg8::Gemm g{(const bf16_t*)WSP(A, WS_HID), (const bf16_t*)(wl + OFF_W2T + s * W2T_BYTES), MLAT, DM, DFF}; pg8::StaticOrder S; S.init(MLAT, DM, G, (int)blockIdx.x);
                  pg8::EpiY E{(bf16_t*)WSP(A, WS_Y), DM}; for (int rep = 0; rep < REP_GEMM; ++rep) pg8::gemm_phase<pg8::EpiY, pg8::StaticOrder, true, true>(lds, g, S, E); }
                GRID_BAR();
            } else {
                { ArgP A = argp(); const unsigned char* wl = WSP(A, WS_W + (size_t)l * W_LAYER);
                  pg8::Gemm g{(const bf16_t*)WSP(A, WS_H), (const bf16_t*)(wl + OFF_WIN), MTOT, INW, DM}; pg8::StaticOrder S; S.init(MTOT, INW, G, (int)blockIdx.x);
                  pg8::EpiProj E{(bf16_t*)WSP(A, WS_HID), INW, (const float*)WSP(A, WS_CS), 0.125f * LOG2E}; for (int rep = 0; rep < REP_GEMM; ++rep) pg8::gemm_phase<pg8::EpiProj, pg8::StaticOrder, true, true>(lds, g, S, E); }
                GRID_BAR();
                {
                    ArgP A = argp();
                    int tid_v = threadIdx.x; asm volatile("" : "+v"(tid_v));
                    const int tid = tid_v, lane = tid & 63, wid = __builtin_amdgcn_readfirstlane(tid >> 6);
                    const bf16_t* PJ = (const bf16_t*)WSP(A, WS_HID); bf16_t* MIX = (bf16_t*)WSP(A, WS_H);
                    const float lam_init = __builtin_bit_cast(float, __builtin_amdgcn_readfirstlane(__builtin_bit_cast(int, (l == 0) ? 0.2f : 0.35550906759096926f)));
                    const float* dl = A->in[14] + l * 256; float d01 = 0.f, d23 = 0.f;
                    for (int i = 0; i < 64; ++i) { d01 = fmaf(dl[i], dl[64 + i], d01); d23 = fmaf(dl[128 + i], dl[192 + i], d23); }
                    const float lam = __expf(d01) - __expf(d23) + lam_init;
                    LAS float* rpbs = (LAS float*)(lds + att::RPB_OFF);
                    for (int rep = 0; rep < REP_MIX; ++rep) {
                    const int nun = (l == 0) ? 264 : 256;
                    for (int rd = 0; rd < REP_DIFF; ++rd)
                    for (int u = blockIdx.x; u < nun; u += G) {
                        if (u < 256) diff_unit(lds, PJ, MIX, (u & 7) >> 2, u & 3, 0, u >> 3, lam, 1.0f - lam_init, A->in[15] + l * 128);
                        else diff_unit(lds, PJ, MIX, ((u - 256) & 7) >> 2, (u - 256) & 3, 1, 0, lam, 1.0f - lam_init, A->in[15] + l * 128);
                    }
                    { int tid2 = threadIdx.x; asm volatile("" : "+v"(tid2)); const float* na_rpb = argp()->in[11]; for (int i = tid2; i < 4 * 465; i += NTHR) rpbs[i] = na_rpb[l * 4 * 465 + i] * LOG2E; }
                    __syncthreads();
                    for (int u = blockIdx.x; u < nun; u += G) {
                        if (u < 256) na_block_unit(lds, rpbs, PJ, MIX, (u >> 1) & 1, u & 1, 0, u >> 2);
                        else na_block_unit(lds, rpbs, PJ, MIX, ((u - 256) >> 1) & 1, (u - 256) & 1, 1, (u - 256) >> 2);
                    }
                    { int tid3 = threadIdx.x; asm volatile("" : "+v"(tid3)); const int lane3 = tid3 & 63, wid3 = __builtin_amdgcn_readfirstlane(tid3 >> 6);
                      for (int u = wid3 * G + (int)blockIdx.x; u < nun * 4; u += ngw)
                        pool_unit(lds + wid3 * att::POOL_WAVE_BYTES, PJ, MIX, argp()->in[12] + l * 4 * 64 * 64, argp()->in[13] + l * 256, u, lane3); }
                    __syncthreads();
                    }
                }
                GRID_BAR();
                for (int rep = 0; rep < EXTRA_SYNC; ++rep) GRID_BAR();
                { ArgP A = argp(); const unsigned char* wl = WSP(A, WS_W + (size_t)l * W_LAYER);
                  const int mrows = (l == 0) ? MTOT : MLAT;
                  pg8::Gemm g{(const bf16_t*)WSP(A, WS_H), (const bf16_t*)(wl + OFF_WOUT), mrows, DM, DM}; pg8::StaticOrder S; S.init(mrows, DM, G, (int)blockIdx.x);
                  pg8::EpiY E{(bf16_t*)WSP(A, WS_Y), DM}; for (int rep = 0; rep < REP_GEMM; ++rep) pg8::gemm_phase<pg8::EpiY, pg8::StaticOrder, true, true>(lds, g, S, E); }
                GRID_BAR();
            }
        }
    }
    {
        ArgP A = argp();
        int tid_v = threadIdx.x; asm volatile("" : "+v"(tid_v));
        const int lane = tid_v & 63, gw = blockIdx.x * NWAVES + __builtin_amdgcn_readfirstlane(tid_v >> 6);
        const float* MODS = (const float*)WSP(A, WS_MODS); float* XC = (float*)WSP(A, WS_XC);
        PrepP p{};
        p.xlat = A->out; p.xctx = XC; p.olat = A->out; p.octx = XC; p.Y = (const bf16_t*)WSP(A, WS_Y); p.has_y = 1;
        p.gate = MODS + (size_t)1 * 3 * NMODW + 8 * 1024; p.gpost = A->in[6] + (size_t)1 * 6 * DM + 5 * DM; p.resw = 0.5f; p.has_h = 0;
        prep_phase(p, gw, ngw, lane);
    }
}

extern "C" void kernel_launch(void* const* d_in, const int* in_sizes, int n_in, void* d_out, int out_size, void* d_ws, size_t ws_size, hipStream_t stream) {
    static int grid = 0;
    if (grid == 0) {
        if (n_in != 16 || out_size != MLAT * DM || ws_size < WS_END) { fprintf(stderr, "kernel_launch: unexpected shapes (n_in %d, out %d, ws %zu)\n", n_in, out_size, ws_size); grid = -1; return; }
        int dev = 0, cus = 0, per_cu = 0;
        if (hipGetDevice(&dev) != hipSuccess || hipDeviceGetAttribute(&cus, hipDeviceAttributeMultiprocessorCount, dev) != hipSuccess) { grid = -1; return; }
        if (hipFuncSetAttribute((const void*)mk_fwd, hipFuncAttributeMaxDynamicSharedMemorySize, LDS_BYTES) != hipSuccess) { fprintf(stderr, "kernel_launch: hipFuncSetAttribute failed\n"); grid = -1; return; }
        if (hipOccupancyMaxActiveBlocksPerMultiprocessor(&per_cu, (const void*)mk_fwd, NTHR, LDS_BYTES) != hipSuccess || per_cu < 1) { fprintf(stderr, "kernel_launch: occupancy query reports %d\n", per_cu); (void)hipGetLastError(); grid = -1; return; }
        grid = cus * per_cu;
        if (grid != 256) { fprintf(stderr, "kernel_launch: this build's unit orders need a 256-workgroup grid (got %d x %d)\n", cus, per_cu); grid = -1; return; }
    }
    if (grid < 0) return;
    if (hipMemsetAsync((char*)d_ws + WS_CTL, 0, CTL_ZERO_BYTES, stream) != hipSuccess) { fprintf(stderr, "kernel_launch: hipMemsetAsync failed\n"); return; }
    Args a{};
    for (int i = 0; i < 16; ++i) a.in[i] = (const float*)d_in[i];
    a.out = (float*)d_out; a.ws = (unsigned char*)d_ws;
    void* args[] = {&a};
    hipError_t e = hipLaunchCooperativeKernel((const void*)mk_fwd, dim3(grid), dim3(NTHR), args, LDS_BYTES, stream);
    if (e != hipSuccess) fprintf(stderr, "kernel_launch: cooperative launch failed: %s (grid %d)\n", hipGetErrorString(e), grid);
}
```
